# Optimizing an MI355X kernel written in HIP

```python
import jax, jax.numpy as jnp
from jax import lax
import numpy as np

D_MODEL = 1024
BATCH = 4
SEQ = 4096
DEPTH = 1
DEC_BATCH = 8
DEC_SEQ = 64
PAST_LEN = 2048

CHUNK = 64
HEAD_DIM = 64
D_MIX = D_MODEL
FOX_HEADS = 8
FOX_W = FOX_HEADS * HEAD_DIM
POOL_GROUPS = 4
POOL_W = D_MIX // 4
POOL_GC = POOL_W // POOL_GROUPS
POOL_WINDOWS = (2, 4, 8, 16)
POOL_STATE = max(POOL_WINDOWS) - 1
MEM_HEADS = 4
MEM_W = MEM_HEADS * HEAD_DIM
MEM_TOKENS = 256
QBLK = 128
EPS = 1e-6
NEG = -1e30
SCALE = HEAD_DIM ** -0.5
IN_SIZES = (FOX_W, FOX_W, FOX_W, FOX_W, FOX_HEADS, POOL_W, POOL_W, MEM_W, MEM_W)
IN_SPLITS = tuple(int(i) for i in np.cumsum(IN_SIZES)[:-1])
D_IN = int(sum(IN_SIZES))

kernel_name = "hymba_fox_pool_mem_stream_step"


def rmsnorm(x, g):
    xf = x.astype(jnp.float32)
    xf = xf * lax.rsqrt(jnp.mean(xf * xf, axis=-1, keepdims=True) + EPS)
    return (xf * g.astype(jnp.float32)).astype(x.dtype)


def project(x, g_norm, w_in, b_f):
    B, S, _ = x.shape
    h = rmsnorm(x, g_norm) @ w_in
    q, k, v, gf, zf, u, gp, qm, gm = jnp.split(h, IN_SPLITS, axis=-1)
    q = q.reshape(B, S, FOX_HEADS, HEAD_DIM)
    k = k.reshape(B, S, FOX_HEADS, HEAD_DIM)
    v = v.reshape(B, S, FOX_HEADS, HEAD_DIM)
    logf = jax.nn.log_sigmoid(zf.astype(jnp.float32) + b_f.astype(jnp.float32))
    qm = qm.reshape(B, S, MEM_HEADS, HEAD_DIM)
    return q, k, v, gf, logf, u, gp, qm, gm


def fox_attend(q, k, v, Fq, Fk, qpos, kpos):
    s = jnp.einsum('bqhd,bkhd->bhqk', q, k).astype(jnp.float32) * SCALE
    bias = jnp.transpose(Fq, (0, 2, 1))[..., :, None] - jnp.transpose(Fk, (0, 2, 1))[..., None, :]
    s = jnp.where(kpos[None, :] <= qpos[:, None], s + bias, NEG)
    p = jax.nn.softmax(s, axis=-1).astype(v.dtype)
    return jnp.einsum('bhqk,bkhd->bqhd', p, v)


def pool_mix(u_ext, n_prefix, pos0, w_pool, pool_scale):
    B, L, C = u_ext.shape
    S = L - n_prefix
    uf = u_ext.astype(jnp.float32)
    cs0 = jnp.concatenate([jnp.zeros((B, 1, C), jnp.float32), jnp.cumsum(uf, axis=1)], axis=1)
    hi = n_prefix + 1 + jnp.arange(S)
    pos = pos0 + jnp.arange(S)
    parts = []
    for gi, w in enumerate(POOL_WINDOWS):
        sl = slice(gi * POOL_GC, (gi + 1) * POOL_GC)
        lo = jnp.maximum(hi - w, 0)
        wsum = cs0[:, hi, sl] - cs0[:, lo, sl]
        cnt = jnp.minimum(w, pos + 1).astype(jnp.float32)
        parts.append(wsum / cnt[None, :, None])
    pooled = jnp.concatenate(parts, axis=-1) - uf[:, n_prefix:]
    pooled = pooled.astype(u_ext.dtype).reshape(B, S, POOL_GROUPS, POOL_GC)
    out = jnp.einsum('bsgc,gcd->bsgd', pooled, w_pool).reshape(B, S, POOL_W)
    return out * pool_scale


def mem_kv(mem, g_mem, w_mem_kv):
    B, M, _ = mem.shape
    kv = rmsnorm(mem, g_mem) @ w_mem_kv
    mk, mv = jnp.split(kv, 2, axis=-1)
    return mk.reshape(B, M, MEM_HEADS, HEAD_DIM), mv.reshape(B, M, MEM_HEADS, HEAD_DIM)


def mem_attend(qm, mk, mv):
    s = jnp.einsum('bqhd,bkhd->bhqk', qm, mk).astype(jnp.float32) * SCALE
    p = jax.nn.softmax(s, axis=-1).astype(mv.dtype)
    return jnp.einsum('bhqk,bkhd->bqhd', p, mv)


def merge(x, fox_o, gf, pool_o, gp, mem_o, gm, w_out):
    B, S, _ = x.shape
    cat = jnp.concatenate([
        jax.nn.silu(gf) * fox_o.reshape(B, S, FOX_W),
        jax.nn.silu(gp) * pool_o,
        jax.nn.silu(gm) * mem_o.reshape(B, S, MEM_W)], axis=-1)
    return x + cat @ w_out


def layer_prompt(x, mem, g_norm, w_in, b_f, w_pool, pool_scale, g_mem, w_mem_kv, w_out):
    B, S, _ = x.shape
    q, k, v, gf, logf, u, gp, qm, gm = project(x, g_norm, w_in, b_f)
    F = jnp.cumsum(logf, axis=1)
    kpos = jnp.arange(S)

    def block(i):
        st = i * QBLK
        qb = lax.dynamic_slice_in_dim(q, st, QBLK, axis=1)
        Fqb = lax.dynamic_slice_in_dim(F, st, QBLK, axis=1)
        return fox_attend(qb, k, v, Fqb, F, st + jnp.arange(QBLK), kpos)

    fox_o = lax.map(block, jnp.arange(S // QBLK))
    fox_o = jnp.transpose(fox_o, (1, 0, 2, 3, 4)).reshape(B, S, FOX_HEADS, HEAD_DIM)
    pool_o = pool_mix(u, 0, 0, w_pool, pool_scale)
    mk, mv = mem_kv(mem, g_mem, w_mem_kv)
    mem_o = mem_attend(qm, mk, mv)
    y = merge(x, fox_o, gf, pool_o, gp, mem_o, gm, w_out)
    return y, k, v, logf.astype(x.dtype), mk, mv, u[:, S - POOL_STATE:]


def layer_sample(x, ck, cv, clogf, cmk, cmv, cpool, g_norm, w_in, b_f, w_pool, pool_scale, w_out):
    B, S, _ = x.shape
    P = ck.shape[1]
    q, k, v, gf, logf, u, gp, qm, gm = project(x, g_norm, w_in, b_f)
    k_all = jnp.concatenate([ck, k], axis=1)
    v_all = jnp.concatenate([cv, v], axis=1)
    F_all = jnp.cumsum(jnp.concatenate([clogf.astype(jnp.float32), logf], axis=1), axis=1)
    fox_o = fox_attend(q, k_all, v_all, F_all[:, P:], F_all, P + jnp.arange(S), jnp.arange(P + S))
    u_ext = jnp.concatenate([cpool.astype(u.dtype), u], axis=1)
    pool_o = pool_mix(u_ext, POOL_STATE, P, w_pool, pool_scale)
    mem_o = mem_attend(qm, cmk, cmv)
    y = merge(x, fox_o, gf, pool_o, gp, mem_o, gm, w_out)
    return y, k, v, logf.astype(x.dtype), u_ext[:, S:]


def setup_inputs(seed: int = 0) -> dict:
    key = jax.random.key(seed)
    ks = jax.random.split(key, 20)
    nrm = jax.random.normal
    f32 = jnp.float32
    return {
        "x_prompt": nrm(ks[0], (BATCH, SEQ, D_MODEL), f32),
        "x_sample": nrm(ks[1], (DEC_BATCH, DEC_SEQ, D_MODEL), f32),
        "mem_prompt": nrm(ks[2], (BATCH, MEM_TOKENS, D_MODEL), f32),
        "cache_fox_k": nrm(ks[3], (DEPTH, DEC_BATCH, PAST_LEN, FOX_HEADS, HEAD_DIM), f32),
        "cache_fox_v": nrm(ks[4], (DEPTH, DEC_BATCH, PAST_LEN, FOX_HEADS, HEAD_DIM), f32),
        "cache_fox_logf": jax.nn.log_sigmoid(3.0 + nrm(ks[5], (DEPTH, DEC_BATCH, PAST_LEN, FOX_HEADS), f32)),
        "cache_mem_k": nrm(ks[6], (DEPTH, DEC_BATCH, MEM_TOKENS, MEM_HEADS, HEAD_DIM), f32),
        "cache_mem_v": nrm(ks[7], (DEPTH, DEC_BATCH, MEM_TOKENS, MEM_HEADS, HEAD_DIM), f32),
        "state_pool": nrm(ks[8], (DEPTH, DEC_BATCH, POOL_STATE, POOL_W), f32),
        "g_norm": 1.0 + 0.02 * nrm(ks[9], (DEPTH, D_MODEL), f32),
        "w_in": nrm(ks[10], (DEPTH, D_MODEL, D_IN), f32) * D_MODEL ** -0.5,
        "b_f": jax.random.uniform(ks[11], (DEPTH, FOX_HEADS), f32, 1.0, 5.0),
        "w_pool": nrm(ks[12], (DEPTH, POOL_GROUPS, POOL_GC, POOL_GC), f32) * POOL_GC ** -0.5,
        "pool_scale": 0.5 + 0.1 * nrm(ks[13], (DEPTH, POOL_W), f32),
        "g_mem": 1.0 + 0.02 * nrm(ks[14], (DEPTH, D_MODEL), f32),
        "w_mem_kv": nrm(ks[15], (DEPTH, D_MODEL, 2 * MEM_W), f32) * D_MODEL ** -0.5,
        "w_out": nrm(ks[16], (DEPTH, D_MIX, D_MODEL), f32) * D_MIX ** -0.5,
        "g_final": 1.0 + 0.02 * nrm(ks[17], (D_MODEL,), f32),
    }


def reference(x_prompt, x_sample, mem_prompt, cache_fox_k, cache_fox_v, cache_fox_logf,
              cache_mem_k, cache_mem_v, state_pool, g_norm, w_in, b_f, w_pool, pool_scale,
              g_mem, w_mem_kv, w_out, g_final):
    hp, hs = x_prompt, x_sample
    kp_l, vp_l, lfp_l, mkp_l, mvp_l, pp_l = [], [], [], [], [], []
    ks_l, vs_l, lfs_l, ps_l = [], [], [], []
    for l in range(DEPTH):
        hp, kp, vp, lfp, mkp, mvp, pp = layer_prompt(
            hp, mem_prompt, g_norm[l], w_in[l], b_f[l], w_pool[l], pool_scale[l],
            g_mem[l], w_mem_kv[l], w_out[l])
        hs, ksn, vsn, lfs, psn = layer_sample(
            hs, cache_fox_k[l], cache_fox_v[l], cache_fox_logf[l], cache_mem_k[l], cache_mem_v[l],
            state_pool[l], g_norm[l], w_in[l], b_f[l], w_pool[l], pool_scale[l], w_out[l])
        kp_l.append(kp); vp_l.append(vp); lfp_l.append(lfp)
        mkp_l.append(mkp); mvp_l.append(mvp); pp_l.append(pp)
        ks_l.append(ksn); vs_l.append(vsn); lfs_l.append(lfs); ps_l.append(psn)
    y_prompt = rmsnorm(hp, g_final)
    y_sample = rmsnorm(hs, g_final)
    return (y_prompt, y_sample,
            jnp.stack(kp_l), jnp.stack(vp_l), jnp.stack(lfp_l),
            jnp.stack(mkp_l), jnp.stack(mvp_l), jnp.stack(pp_l),
            jnp.stack(ks_l), jnp.stack(vs_l), jnp.stack(lfs_l), jnp.stack(ps_l))
```

```cpp
#include <hip/hip_runtime.h>
#include <hip/hip_cooperative_groups.h>
#include <cstdio>
#include <cstdint>
namespace cg = cooperative_groups;
namespace pg8 {
#define PG8_LAS __attribute__((address_space(3)))
typedef unsigned short bf16_t;
typedef short bf16x8 __attribute__((ext_vector_type(8)));
typedef float f32x4 __attribute__((ext_vector_type(4)));
typedef unsigned u32x4 __attribute__((ext_vector_type(4)));
constexpr int BM = 256, BK = 64, HALF = 128, HTB = HALF * BK * 2  , STAGE_BYTES = 8 * HTB, NXCD = 8, WGM = 8;

__host__ __device__ __forceinline__ int lds_byte(int r, int c) { const int st = (r >> 4) * 2 + (c >> 5), rr = r & 15, cc = c & 31, ob = rr * 64 + cc * 2; return st * 1024 + (ob ^ (((ob >> 9) & 1) << 5)); }
__host__ __device__ __forceinline__ void stage_rc(int b, int& R, int& C) { const int st = b / 1024, sb = b % 1024, swz = sb ^ (((sb >> 9) & 1) << 5); R = (st >> 1) * 16 + swz / 64; C = (st & 1) * 32 + (swz % 64) / 2; }
__host__ __device__ __forceinline__ int perm32(int rho) { const int n = rho >> 4, i = rho & 15; return 8 * (i >> 2) + 4 * n + (i & 3); }

struct Unit { int pm, pn; };
struct Gemm { const bf16_t* A; const bf16_t* Bt; int M, N, K; };

struct StaticOrder {
    int nM, nN, nwg, G, c;
    __host__ __device__ void init(int M, int N, int G_, int c_) { nM = M / BM; nN = N / BM; nwg = nM * nN; G = G_; c = c_; }
    __host__ __device__ bool next(int i, Unit& u) const {
        const long L = (long)i * G + c; if (L >= nwg) return false;
        int wgid = (int)L; { const int q = nwg / NXCD, r = nwg % NXCD, xcd = wgid % NXCD, off = wgid / NXCD; wgid = (xcd < r ? xcd * (q + 1) : r * (q + 1) + (xcd - r) * q) + off; }
        const int nig = WGM * nN, gid = wgid / nig, fm = gid * WGM, gsz = (nM - fm) < WGM ? (nM - fm) : WGM;
        u.pm = fm + ((wgid % nig) % gsz); u.pn = (wgid % nig) / gsz; return true;
    }
    __device__ __forceinline__ void a_ready(const Unit&) const {}
    __device__ __forceinline__ void done(const Unit&) const {}
};

__device__ __forceinline__ unsigned cvt_pk_bf16(float lo, float hi) { unsigned r; asm volatile("v_cvt_pk_bf16_f32 %0, %1, %2" : "=v"(r) : "v"(lo), "v"(hi)); return r; }
template <class Epi, class Sched, bool ALIGN_EPI = false, bool SP2 = false>
__device__ __forceinline__ void gemm_phase(PG8_LAS unsigned char* lds, const Gemm g, const Sched& S, const Epi& E) {
    int tid_l = threadIdx.x; asm volatile("" : "+v"(tid_l));
    const int tid = tid_l, wid = __builtin_amdgcn_readfirstlane(tid >> 6), lane = tid & 63, wr = wid >> 2, wc = wid & 3, fr = lane & 15, fq = lane >> 4;
    const int K = g.K, nt = K / BK;
    unsigned voffA[2], voffB[2];
#pragma unroll
    for (int i = 0; i < 2; ++i) { int R, C; stage_rc(tid * 16 + i * 8192, R, C); const int Rb = Epi::PERM ? ((R & ~31) + perm32(R & 31)) : R;
        voffA[i] = (unsigned)(R * K + C) * 2u; voffB[i] = (unsigned)(Rb * K + C) * 2u; }
    const size_t kstep = (size_t)(BK * 2);
    const size_t hstep = (size_t)HALF * K * 2;
    const size_t tstep = 2 * hstep;
    const unsigned ldsw = (unsigned)wid * 1024u;
    const int aoff = lds_byte(wr * 64 + fr, fq * 8), boff = lds_byte(wc * 32 + fr, fq * 8);
#define PG8_SA(b, h) (((b) * 2 + (h)) * HTB)
#define PG8_SB(b, h) ((4 + (b) * 2 + (h)) * HTB)
#define PG8_STAGE(bufoff, gbase, voff) do { _Pragma("unroll") for (int _i = 0; _i < 2; ++_i) \
        __builtin_amdgcn_global_load_lds((const unsigned*)((const char*)(gbase) + (voff)[_i]), (PG8_LAS unsigned*)(lds + (bufoff) + ldsw + _i * 8192), 16, 0, 0); } while (0)
#define PG8_LDA(dst, b, h) do { _Pragma("unroll") for (int m = 0; m < 4; ++m) _Pragma("unroll") for (int k = 0; k < 2; ++k) dst[m][k] = *(const PG8_LAS bf16x8*)(lds + PG8_SA(b, h) + aoff + m * 2048 + k * 1024); } while (0)
#define PG8_LDB(dst, b, h) do { _Pragma("unroll") for (int n = 0; n < 2; ++n) _Pragma("unroll") for (int k = 0; k < 2; ++k) dst[n][k] = *(const PG8_LAS bf16x8*)(lds + PG8_SB(b, h) + boff + n * 2048 + k * 1024); } while (0)
#define PG8_MMA(ai, bj, At, Bt) do { __builtin_amdgcn_s_setprio(1); _Pragma("unroll") for (int m = 0; m < 4; ++m) _Pragma("unroll") for (int n = 0; n < 2; ++n) _Pragma("unroll") for (int k = 0; k < 2; ++k) \
        acc[ai][bj][m][n] = __builtin_amdgcn_mfma_f32_16x16x32_bf16(Bt[n][k], At[m][k], acc[ai][bj][m][n], 0, 0, 0); __builtin_amdgcn_s_setprio(0); } while (0)
#define PG8_WAIT_V(n) asm volatile("s_waitcnt vmcnt(" #n ")" ::: "memory")
#define PG8_WAIT_L(n) asm volatile("s_waitcnt lgkmcnt(" #n ")" ::: "memory")
#define PG8_BAR __builtin_amdgcn_s_barrier()
#define PG8_SCHED __builtin_amdgcn_sched_barrier(0)
    Unit cur, nxt; int ui = 0;
    if (!S.next(0, cur)) return;
    f32x4 acc[2][2][4][2];
#pragma unroll
    for (int a = 0; a < 2; ++a)
#pragma unroll
        for (int b = 0; b < 2; ++b)
#pragma unroll
            for (int m = 0; m < 4; ++m)
#pragma unroll
                for (int n = 0; n < 2; ++n) acc[a][b][m][n] = (f32x4){0.f, 0.f, 0.f, 0.f};
    bf16x8 At[4][2], B0[2][2], B1[2][2];
    const char* cA = (const char*)g.A + (size_t)cur.pm * tstep; const char* cB = (const char*)g.Bt + (size_t)cur.pn * tstep;
    S.a_ready(cur);
    if constexpr (SP2) {
        PG8_STAGE(PG8_SB(0, 0), cB, voffB); PG8_STAGE(PG8_SB(0, 1), cB + hstep, voffB); PG8_STAGE(PG8_SA(0, 0), cA, voffA); PG8_STAGE(PG8_SA(0, 1), cA + hstep, voffA);
        if (wr == 1) PG8_BAR;
        PG8_WAIT_V(2); PG8_BAR;
        PG8_STAGE(PG8_SB(1, 0), cB + kstep, voffB); PG8_STAGE(PG8_SA(1, 0), cA + kstep, voffA); PG8_STAGE(PG8_SB(1, 1), cB + hstep + kstep, voffB);
        PG8_WAIT_V(6); PG8_BAR;
    } else {
        PG8_STAGE(PG8_SB(0, 0), cB, voffB); PG8_STAGE(PG8_SA(0, 0), cA, voffA); PG8_STAGE(PG8_SB(0, 1), cB + hstep, voffB); PG8_STAGE(PG8_SA(0, 1), cA + hstep, voffA);
        if (wr == 1) PG8_BAR;
        PG8_WAIT_V(4); PG8_BAR;
        PG8_STAGE(PG8_SB(1, 0), cB + kstep, voffB); PG8_STAGE(PG8_SA(1, 0), cA + kstep, voffA); PG8_STAGE(PG8_SB(1, 1), cB + hstep + kstep, voffB);
        PG8_WAIT_V(6); PG8_BAR;
    }
    for (;;) {
        const bool has_next = S.next(ui + 1, nxt);
        const char* nA = has_next ? (const char*)g.A + (size_t)nxt.pm * tstep : cA; const char* nB = has_next ? (const char*)g.Bt + (size_t)nxt.pn * tstep : cB;
        for (int t = 0; t < nt; t += 2) {
            const bool last = (t == nt - 2);
            const char* a1 = cA + (size_t)(t + 1) * kstep;
            const char* a2 = last ? nA : cA + (size_t)(t + 2) * kstep; const char* b2 = last ? nB : cB + (size_t)(t + 2) * kstep;
            const char* a3 = a2 + kstep; const char* b3 = b2 + kstep;
            if (last && has_next) S.a_ready(nxt);
            if constexpr (SP2) {
            PG8_LDB(B0, 0, 0); PG8_LDB(B1, 0, 1); PG8_SCHED; PG8_LDA(At, 0, 0); PG8_STAGE(PG8_SA(1, 1), a1 + hstep, voffA);
            PG8_WAIT_V(8); PG8_WAIT_L(0); PG8_BAR; PG8_MMA(0, 0, At, B0); PG8_MMA(0, 1, At, B1); PG8_BAR; PG8_SCHED;
            PG8_LDA(At, 0, 1); PG8_STAGE(PG8_SB(0, 0), b2, voffB); PG8_STAGE(PG8_SB(0, 1), b2 + hstep, voffB); PG8_STAGE(PG8_SA(0, 0), a2, voffA);
            PG8_WAIT_V(8); PG8_WAIT_L(0); PG8_BAR; PG8_MMA(1, 0, At, B0); PG8_MMA(1, 1, At, B1); PG8_BAR; PG8_SCHED;
            PG8_LDB(B0, 1, 0); PG8_LDB(B1, 1, 1); PG8_SCHED; PG8_LDA(At, 1, 0); PG8_STAGE(PG8_SA(0, 1), a2 + hstep, voffA);
            PG8_WAIT_V(8); PG8_WAIT_L(0); PG8_BAR; PG8_MMA(0, 0, At, B0); PG8_MMA(0, 1, At, B1); PG8_BAR; PG8_SCHED;
            PG8_LDA(At, 1, 1); PG8_STAGE(PG8_SB(1, 0), b3, voffB); PG8_STAGE(PG8_SB(1, 1), b3 + hstep, voffB); PG8_STAGE(PG8_SA(1, 0), a3, voffA);
            PG8_WAIT_V(8); PG8_WAIT_L(0); PG8_BAR; PG8_MMA(1, 0, At, B0); PG8_MMA(1, 1, At, B1); PG8_BAR; PG8_SCHED;
            } else {
            PG8_LDB(B0, 0, 0); PG8_SCHED; PG8_LDA(At, 0, 0); PG8_STAGE(PG8_SA(1, 1), a1 + hstep, voffA);
            PG8_WAIT_L(8); PG8_BAR; PG8_WAIT_L(0); PG8_MMA(0, 0, At, B0); PG8_BAR; PG8_SCHED;
            PG8_LDB(B1, 0, 1); PG8_STAGE(PG8_SB(0, 0), b2, voffB);
            PG8_BAR; PG8_WAIT_L(0); PG8_MMA(0, 1, At, B1); PG8_BAR;
            PG8_LDA(At, 0, 1); PG8_STAGE(PG8_SA(0, 0), a2, voffA);
            PG8_BAR; PG8_WAIT_L(0); PG8_MMA(1, 0, At, B0); PG8_BAR; PG8_SCHED;
            PG8_STAGE(PG8_SB(0, 1), b2 + hstep, voffB);
            PG8_WAIT_V(6); PG8_BAR; PG8_MMA(1, 1, At, B1); PG8_BAR;
            PG8_LDB(B0, 1, 0); PG8_SCHED; PG8_LDA(At, 1, 0); PG8_STAGE(PG8_SA(0, 1), a2 + hstep, voffA);
            PG8_WAIT_L(8); PG8_BAR; PG8_WAIT_L(0); PG8_MMA(0, 0, At, B0); PG8_BAR; PG8_SCHED;
            PG8_LDB(B1, 1, 1); PG8_STAGE(PG8_SB(1, 0), b3, voffB);
            PG8_BAR; PG8_WAIT_L(0); PG8_MMA(0, 1, At, B1); PG8_BAR;
            PG8_LDA(At, 1, 1); PG8_STAGE(PG8_SA(1, 0), a3, voffA);
            PG8_BAR; PG8_WAIT_L(0); PG8_MMA(1, 0, At, B0); PG8_BAR; PG8_SCHED;
            PG8_STAGE(PG8_SB(1, 1), b3 + hstep, voffB);
            PG8_WAIT_V(6); PG8_BAR; PG8_MMA(1, 1, At, B1); PG8_BAR;
            }
        }
        if constexpr (ALIGN_EPI) { if (wr == 0) PG8_BAR; }
        if constexpr (!Epi::AFTER_DRAIN) { E(acc, cur, wr, wc, fr, fq); S.done(cur); }
        if (!has_next) break;
#pragma unroll
        for (int a = 0; a < 2; ++a)
#pragma unroll
            for (int b = 0; b < 2; ++b)
#pragma unroll
                for (int m = 0; m < 4; ++m)
#pragma unroll
                    for (int n = 0; n < 2; ++n) acc[a][b][m][n] = (f32x4){0.f, 0.f, 0.f, 0.f};
        cur = nxt; cA = nA; cB = nB; ++ui;
        if constexpr (ALIGN_EPI) { if (wr == 1) PG8_BAR; }
    }
    PG8_WAIT_V(0);
    if constexpr (!ALIGN_EPI) { if (wr == 0) PG8_BAR; }
    PG8_BAR;
    if constexpr (Epi::AFTER_DRAIN) { E.fused(acc, cur, wr, wc, fr, fq, lds, wid, lane); S.done(cur); }
#undef PG8_SA
#undef PG8_SB
#undef PG8_STAGE
#undef PG8_LDA
#undef PG8_LDB
#undef PG8_MMA
#undef PG8_WAIT_V
#undef PG8_WAIT_L
#undef PG8_BAR
#undef PG8_SCHED
}
}

#define LAS __attribute__((address_space(3)))
typedef unsigned short bf16_t;
typedef float f32x4 __attribute__((ext_vector_type(4)));
typedef float f32x16 __attribute__((ext_vector_type(16)));
typedef short bf16x8 __attribute__((ext_vector_type(8)));
typedef short s16x4 __attribute__((ext_vector_type(4)));
typedef unsigned u32x4 __attribute__((ext_vector_type(4)));
typedef unsigned u32x2 __attribute__((ext_vector_type(2)));
typedef float f32x2_t __attribute__((ext_vector_type(2)));
typedef __bf16 bf16x2_t __attribute__((ext_vector_type(2)));

constexpr int DM = 1024, NB = 4, SEQ = 4096, DB = 8, DSEQ = 64, PAST = 2048, KTOT = PAST + DSEQ;
constexpr int FH = 8, HD = 64, MHEADS = 4, MEMT = 256, DIN = 3080;
constexpr int MP = NB * SEQ, MS = DB * DSEQ, MTOT = MP + MS, MMEM = NB * MEMT;
constexpr int NH = 3072;
constexpr int C_Q = 0, C_K = 512, C_V = 1024, C_GF = 1536, C_U = 2048, C_GP = 2304, C_QM = 2560, C_GM = 2816;
constexpr float EPS = 1e-6f, LOG2E = 1.4426950408889634f, C2 = 0.125f * LOG2E;
constexpr size_t O_Y = 0, O_K_P = 17301504, O_V_P = 25690112, O_LF_P = 34078720, O_MK_P = 34209792, O_MV_P = 34471936,
                 O_POOL_P = 34734080, O_K_S = 34749440, O_V_S = 35011584, O_LF_S = 35273728, O_POOL_S = 35277824;
constexpr size_t MiB = 1u << 20;
constexpr size_t WS_CTL = 0, WS_WIN = 1 * MiB, WS_WMEM = 7 * MiB, WS_WOUT = 8 * MiB, WS_MEMN = 10 * MiB, WS_MKV = 12 * MiB, WS_CMK = 13 * MiB,
                 WS_CMV = 14 * MiB, WS_BIASP = 15 * MiB, WS_BIASS = 16 * MiB, WS_KC = 17 * MiB, WS_VC = 34 * MiB, WS_XN = 51 * MiB, WS_H = 84 * MiB,
                 WS_END = 183 * MiB;
constexpr int LDS_BYTES = 147456;
constexpr int LDS_Q = 140000;

struct Params {
    const float *x_prompt, *x_sample, *mem_prompt, *cache_k, *cache_v, *cache_logf, *cache_mk, *cache_mv, *state_pool;
    const float *g_norm, *w_in, *b_f, *w_pool, *pool_scale, *g_mem, *w_mem_kv, *w_out, *g_final;
    float* out; unsigned char* ws;
};

__device__ __forceinline__ unsigned pk2(float lo, float hi) { f32x2_t v = {lo, hi}; bf16x2_t b = __builtin_convertvector(v, bf16x2_t); return __builtin_bit_cast(unsigned, b); }
__device__ __forceinline__ float bf_lo(unsigned u) { return __uint_as_float(u << 16); }
__device__ __forceinline__ float bf_hi(unsigned u) { return __uint_as_float(u & 0xffff0000u); }
__device__ __forceinline__ float wave_sum(float v) {
#pragma unroll
    for (int o = 1; o < 64; o <<= 1) v += __shfl_xor(v, o);
    return v;
}
__device__ __forceinline__ float silu_f(float x) { return x * __builtin_amdgcn_rcpf(1.f + __expf(-x)); }
__device__ __forceinline__ int crow(int r, int hi) { return (r & 3) + 8 * (r >> 2) + 4 * hi; }
#define MFMA32(a, b, c) __builtin_amdgcn_mfma_f32_32x32x16_bf16((a), (b), (c), 0, 0, 0)

namespace pg8 {
struct EpiIn {
    static constexpr bool PERM = true, AFTER_DRAIN = false;
    bf16_t* H; float* out; bf16_t* KC; bf16_t* VC;
    __device__ __forceinline__ void operator()(const f32x4 (&acc)[2][2][4][2], const Unit& u, int wr, int wc, int fr, int fq) const {
        const int pn = u.pn;
        const float sc = (pn < 2 || pn == 10) ? C2 : 1.f;
        const int row0 = u.pm * BM + wr * 64 + fr, colb = pn * BM + wc * 32 + 8 * fq;
#pragma unroll
        for (int ai = 0; ai < 2; ++ai)
#pragma unroll
            for (int m = 0; m < 4; ++m) {
                const int row = row0 + ai * HALF + m * 16;
#pragma unroll
                for (int bj = 0; bj < 2; ++bj) {
                    const int col = colb + bj * HALF;
                    const f32x4 v0 = acc[ai][bj][m][0], v1 = acc[ai][bj][m][1];
                    u32x4 w; w.x = pk2(v0[0] * sc, v0[1] * sc); w.y = pk2(v0[2] * sc, v0[3] * sc); w.z = pk2(v1[0] * sc, v1[1] * sc); w.w = pk2(v1[2] * sc, v1[3] * sc);
                    *(u32x4*)(H + (size_t)row * NH + col) = w;
                    if (pn >= 2 && pn < 6) {
                        const bool isv = pn >= 4; const int c = col - (isv ? C_V : C_K);
                        float* dst;
                        if (row < MP) dst = out + (isv ? O_V_P : O_K_P) + (size_t)row * 512 + c;
                        else { const int rs = row - MP; dst = out + (isv ? O_V_S : O_K_S) + (size_t)rs * 512 + c;
                               bf16_t* cd = (isv ? VC : KC) + ((size_t)(rs >> 6) * KTOT + PAST + (rs & 63)) * 512 + c; *(u32x4*)cd = w; }
                        *(f32x4*)dst = v0; *(f32x4*)(dst + 4) = v1;
                    } else if (pn == 8) {
                        const int c = col - C_U; float* dst = nullptr;
                        if (row < MP) { const int s = row & (SEQ - 1); if (s >= SEQ - 15) dst = out + O_POOL_P + ((size_t)(row >> 12) * 15 + (s - (SEQ - 15))) * 256 + c; }
                        else { const int rs = row - MP, s = rs & 63; if (s >= DSEQ - 15) dst = out + O_POOL_S + ((size_t)(rs >> 6) * 15 + (s - (DSEQ - 15))) * 256 + c; }
                        if (dst) { *(f32x4*)dst = v0; *(f32x4*)(dst + 4) = v1; }
                    }
                }
            }
    }
};
struct EpiMem {
    static constexpr bool PERM = true, AFTER_DRAIN = false;
    bf16_t* MKV; float* out;
    __device__ __forceinline__ void operator()(const f32x4 (&acc)[2][2][4][2], const Unit& u, int wr, int wc, int fr, int fq) const {
        const int row0 = u.pm * BM + wr * 64 + fr, colb = u.pn * BM + wc * 32 + 8 * fq;
        float* ob = out + (u.pn ? O_MV_P : O_MK_P);
#pragma unroll
        for (int ai = 0; ai < 2; ++ai)
#pragma unroll
            for (int m = 0; m < 4; ++m) {
                const int row = row0 + ai * HALF + m * 16;
#pragma unroll
                for (int bj = 0; bj < 2; ++bj) {
                    const int col = colb + bj * HALF;
                    const f32x4 v0 = acc[ai][bj][m][0], v1 = acc[ai][bj][m][1];
                    u32x4 w; w.x = pk2(v0[0], v0[1]); w.y = pk2(v0[2], v0[3]); w.z = pk2(v1[0], v1[1]); w.w = pk2(v1[2], v1[3]);
                    *(u32x4*)(MKV + (size_t)row * 512 + col) = w;
                    float* dst = ob + (size_t)row * 256 + (col - u.pn * BM);
                    *(f32x4*)dst = v0; *(f32x4*)(dst + 4) = v1;
                }
            }
    }
};
struct EpiOut {
    static constexpr bool PERM = false, AFTER_DRAIN = false;
    const float* xp; const float* xs; float* y;
    __device__ __forceinline__ void operator()(const f32x4 (&acc)[2][2][4][2], const Unit& u, int wr, int wc, int fr, int fq) const {
        const int row0 = u.pm * BM + wr * 64 + fr, colb = u.pn * BM + wc * 32 + 4 * fq;
        const float* xb = (u.pm * BM < MP) ? xp : (xs - (size_t)MP * DM);
#pragma unroll
        for (int ai = 0; ai < 2; ++ai)
#pragma unroll
            for (int m = 0; m < 4; ++m) {
                const size_t off = (size_t)(row0 + ai * HALF + m * 16) * DM + colb;
#pragma unroll
                for (int bj = 0; bj < 2; ++bj)
#pragma unroll
                    for (int n = 0; n < 2; ++n) {
                        const f32x4 xv = *(const f32x4*)(xb + off + bj * HALF + n * 16);
                        *(f32x4*)(y + off + bj * HALF + n * 16) = xv + acc[ai][bj][m][n];
                    }
            }
    }
};
}

__device__ __forceinline__ void transpose_item(const float* W, int pitch, int src_col0, bf16_t* WT, int K, int dst_row0, int k0, LAS float* scr, int lane) {
#pragma unroll 8
    for (int i = 0; i < 32; ++i) { const int kk = 2 * i + (lane >> 5); scr[kk * 33 + (lane & 31)] = W[(size_t)(k0 + kk) * pitch + src_col0 + (lane & 31)]; }
    asm volatile("s_waitcnt lgkmcnt(0)" ::: "memory");
    const int c = lane & 7;
#pragma unroll
    for (int j = 0; j < 4; ++j) { const int n = (lane >> 3) + 8 * j; const LAS float* s = scr + (8 * c) * 33 + n;
        u32x4 o; o.x = pk2(s[0 * 33], s[1 * 33]); o.y = pk2(s[2 * 33], s[3 * 33]); o.z = pk2(s[4 * 33], s[5 * 33]); o.w = pk2(s[6 * 33], s[7 * 33]);
        *(u32x4*)(WT + (size_t)(dst_row0 + n) * K + k0 + 8 * c) = o; }
    asm volatile("s_waitcnt lgkmcnt(0)" ::: "memory");
}

__device__ __forceinline__ float log_sigmoid_f(float t) { return fminf(t, 0.f) - log1pf(__expf(-fabsf(t))); }

template <bool ZF>
__device__ __forceinline__ void norm_row(const float* xrow, const float* g, bf16_t* orow, int lane, const LAS float* wz, const float* bfv, float* lf_out) {
    const f32x4* xr = (const f32x4*)xrow + lane; const f32x4* gr = (const f32x4*)g + lane;
    f32x4 v[4]; float s = 0.f;
#pragma unroll
    for (int j = 0; j < 4; ++j) { v[j] = xr[64 * j]; s += (v[j].x * v[j].x + v[j].y * v[j].y) + (v[j].z * v[j].z + v[j].w * v[j].w); }
    const float rs = 1.0f / sqrtf(wave_sum(s) * (1.f / DM) + EPS);
    unsigned long long* o8 = (unsigned long long*)orow + lane;
#pragma unroll
    for (int j = 0; j < 4; ++j) { const f32x4 gv = gr[64 * j]; v[j] = v[j] * rs * gv;
        o8[64 * j] = (unsigned long long)pk2(v[j].x, v[j].y) | ((unsigned long long)pk2(v[j].z, v[j].w) << 32); }
    if (ZF) {
        float z[8];
#pragma unroll
        for (int hh = 0; hh < 8; ++hh) { float a = 0.f;
#pragma unroll
            for (int j = 0; j < 4; ++j) { const f32x4 w = *(const LAS f32x4*)(wz + hh * DM + 4 * (lane + 64 * j)); a += (v[j].x * w.x + v[j].y * w.y) + (v[j].z * w.z + v[j].w * w.w); }
            z[hh] = wave_sum(a); }
        float zz = z[0];
#pragma unroll
        for (int hh = 1; hh < 8; ++hh) zz = (lane == hh) ? z[hh] : zz;
        if (lane < 8) lf_out[lane] = log_sigmoid_f(zz + bfv[lane]);
    }
}

__device__ __forceinline__ void p0_prologue(const Params& P, LAS unsigned char* lds, int tid, int G) {
    asm volatile("" : "+v"(tid));
    const int lane = tid & 63, wave = tid >> 6;
    unsigned char* ws = P.ws;
    bf16_t* WIN = (bf16_t*)(ws + WS_WIN); bf16_t* WMEM = (bf16_t*)(ws + WS_WMEM); bf16_t* WOUT = (bf16_t*)(ws + WS_WOUT);
    bf16_t* XN = (bf16_t*)(ws + WS_XN); bf16_t* MEMN = (bf16_t*)(ws + WS_MEMN);
    if (blockIdx.x == 0 && tid == 0) *(unsigned*)(ws + WS_CTL) = 0u;
    LAS float* wz = (LAS float*)(lds + 73728);
    for (int e = tid; e < 8 * DM; e += 512) { const int k = e >> 3, j = e & 7; wz[j * DM + k] = P.w_in[(size_t)k * DIN + 2048 + j]; }
    LAS float* scr = (LAS float*)(lds + wave * 8704);
    const int gw = blockIdx.x * 8 + wave, NGW = G * 8;
    constexpr int I_IN = 16 * 96, I_MEM = 16 * 16, I_OUT = 16 * 32;
    for (int it = gw; it < I_IN + I_MEM + I_OUT; it += NGW) {
        int r = it;
        if (r < I_IN) { const int kb = r / 96, nb = r % 96, n0 = 32 * nb; transpose_item(P.w_in, DIN, n0 < 2048 ? n0 : n0 + 8, WIN, DM, n0, 64 * kb, scr, lane); continue; }
        r -= I_IN;
        if (r < I_MEM) { const int kb = r / 16, nb = r % 16; transpose_item(P.w_mem_kv, 512, 32 * nb, WMEM, DM, 32 * nb, 64 * kb, scr, lane); continue; }
        r -= I_MEM;
        { const int kb = r / 32, nb = r % 32; transpose_item(P.w_out, DM, 32 * nb, WOUT, DM, 32 * nb, 64 * kb, scr, lane); }
    }
    __syncthreads();
    for (int m = gw; m < MTOT + MMEM; m += NGW) {
        if (m < MP) norm_row<true>(P.x_prompt + (size_t)m * DM, P.g_norm, XN + (size_t)m * DM, lane, wz, P.b_f, P.out + O_LF_P + (size_t)m * 8);
        else if (m < MTOT) norm_row<true>(P.x_sample + (size_t)(m - MP) * DM, P.g_norm, XN + (size_t)m * DM, lane, wz, P.b_f, P.out + O_LF_S + (size_t)(m - MP) * 8);
        else norm_row<false>(P.mem_prompt + (size_t)(m - MTOT) * DM, P.g_mem, MEMN + (size_t)(m - MTOT) * DM, lane, wz, nullptr, nullptr);
    }
    const int gt = blockIdx.x * 512 + tid, NGT = G * 512;
    bf16_t* KC = (bf16_t*)(ws + WS_KC); bf16_t* VC = (bf16_t*)(ws + WS_VC); bf16_t* CMK = (bf16_t*)(ws + WS_CMK); bf16_t* CMV = (bf16_t*)(ws + WS_CMV);
    constexpr int PER_B = PAST * 512, NCK = DB * PER_B / 8;
    for (int i = gt; i < 2 * NCK; i += NGT) {
        const bool isv = i >= NCK; const int i8 = (isv ? i - NCK : i) * 8; const int b = i8 / PER_B, within = i8 - b * PER_B;
        const float* src = (isv ? P.cache_v : P.cache_k) + i8;
        const f32x4 a = *(const f32x4*)src, c = *(const f32x4*)(src + 4);
        u32x4 w; w.x = pk2(a.x, a.y); w.y = pk2(a.z, a.w); w.z = pk2(c.x, c.y); w.w = pk2(c.z, c.w);
        *(u32x4*)((isv ? VC : KC) + (size_t)b * KTOT * 512 + within) = w;
    }
    constexpr int NCM = DB * MEMT * 256 / 8;
    for (int i = gt; i < 2 * NCM; i += NGT) {
        const bool isv = i >= NCM; const int i8 = (isv ? i - NCM : i) * 8;
        const float* src = (isv ? P.cache_mv : P.cache_mk) + i8;
        const f32x4 a = *(const f32x4*)src, c = *(const f32x4*)(src + 4);
        u32x4 w; w.x = pk2(a.x, a.y); w.y = pk2(a.z, a.w); w.z = pk2(c.x, c.y); w.w = pk2(c.z, c.w);
        *(u32x4*)((isv ? CMV : CMK) + i8) = w;
    }
}

__device__ __forceinline__ void scan_seq(const Params& P, int sid, LAS unsigned char* lds, int tid) {
    asm volatile("" : "+v"(tid));
    const int lane = tid & 63, wave = tid >> 6;
    LAS float* wt = (LAS float*)lds;
    int L; float* dst; const float* src0; const float* src1; int split;
    if (sid < 32) { const int b = sid >> 3, h = sid & 7; L = SEQ; split = SEQ; src0 = P.out + O_LF_P + (size_t)b * SEQ * 8 + h; src1 = src0; dst = (float*)(P.ws + WS_BIASP) + (size_t)sid * SEQ; }
    else { const int s2 = sid - 32, b = s2 >> 3, h = s2 & 7; L = KTOT; split = PAST; src0 = P.cache_logf + (size_t)b * PAST * 8 + h;
           src1 = P.out + O_LF_S + (size_t)b * DSEQ * 8 + h - (size_t)PAST * 8; dst = (float*)(P.ws + WS_BIASS) + (size_t)s2 * KTOT; }
    float v[8]; float run = 0.f;
#pragma unroll
    for (int j = 0; j < 8; ++j) { const int pos = tid * 8 + j; float x = 0.f; if (pos < L) x = (pos < split) ? src0[(size_t)pos * 8] : src1[(size_t)pos * 8]; run += x; v[j] = run; }
    float inc = run;
#pragma unroll
    for (int o = 1; o < 64; o <<= 1) { const float t = __shfl_up(inc, o); if (lane >= o) inc += t; }
    if (lane == 63) wt[wave] = inc;
    __syncthreads();
    float base = inc - run;
    for (int w = 0; w < wave; ++w) base += wt[w];
#pragma unroll
    for (int j = 0; j < 8; ++j) { const int pos = tid * 8 + j; if (pos < L) dst[pos] = -(base + v[j]) * LOG2E; }
    __syncthreads();
}

struct AUnit { const bf16_t* Q; const bf16_t* K; const bf16_t* V; const float* bias; const bf16_t* G; bf16_t* O; int qp, kvp, gp, op, nq, ntiles, qpos0, causal; };

__device__ __forceinline__ s16x4 vtr(const LAS unsigned char* p) {
    typedef short v4i16_t __attribute__((ext_vector_type(4)));
    return __builtin_bit_cast(s16x4, __builtin_amdgcn_ds_read_tr16_b64_v4i16((LAS v4i16_t*)p));
}
__device__ __forceinline__ float swapmax(float m) { auto rr = __builtin_amdgcn_permlane32_swap(__float_as_uint(m), __float_as_uint(m), false, false); return fmaxf(__uint_as_float(rr[0]), __uint_as_float(rr[1])); }
__device__ __forceinline__ float swapsum(float m) { auto rr = __builtin_amdgcn_permlane32_swap(__float_as_uint(m), __float_as_uint(m), false, false); return __uint_as_float(rr[0]) + __uint_as_float(rr[1]); }

__device__ __forceinline__ void attn_unit(const AUnit& U, LAS unsigned char* lds, int tid) {
    asm volatile("" : "+v"(tid));
    constexpr int KROW = 144, TILEB = 64 * KROW;
    const int lane = tid & 63, w = __builtin_amdgcn_readfirstlane(tid >> 6), r = lane & 31, h = lane >> 5;
    LAS unsigned char* Kb = lds; LAS unsigned char* Vb = lds + 2 * TILEB; LAS float* Bb = (LAS float*)(lds + 4 * TILEB);
    const bool active = (32 * w < U.nq);
    const int skey = tid >> 3, sch = tid & 7;
    const bf16_t* kg = U.K + (size_t)skey * U.kvp + sch * 8;
    const bf16_t* vg = U.V + (size_t)skey * U.kvp + sch * 8;
    const unsigned soff = skey * KROW + sch * 16;
    const size_t tstride = (size_t)64 * U.kvp;
    bf16x8 qf[4];
#pragma unroll
    for (int d0 = 0; d0 < 4; ++d0) qf[d0] = (bf16x8){0, 0, 0, 0, 0, 0, 0, 0};
    if (active) { const bf16_t* qrow = U.Q + (size_t)(32 * w + r) * U.qp + 8 * h;
#pragma unroll
        for (int d0 = 0; d0 < 4; ++d0) qf[d0] = *(const bf16x8*)(qrow + 16 * d0); }
    float m = -1e30f, l = 0.f; f32x16 o0, o1;
#pragma unroll
    for (int i = 0; i < 16; ++i) { o0[i] = 0.f; o1[i] = 0.f; }
    const int qpos = U.qpos0 + 32 * w + r;
    const int tlast = U.causal ? ((U.qpos0 + 32 * w + 31) >> 6) : (U.ntiles - 1);
    const bool hasb = (U.bias != nullptr) && (tid < 64);
    u32x4 kreg = *(const u32x4*)kg, vreg = *(const u32x4*)vg; float breg = hasb ? U.bias[tid] : 0.f;
    *(LAS u32x4*)(Kb + soff) = kreg; *(LAS u32x4*)(Vb + soff) = vreg; if (tid < 64) Bb[tid] = breg;
    __syncthreads();
    const int q4 = (lane & 15) >> 2, p4 = lane & 3, blk = (lane >> 4) & 1;
    const unsigned voff = (4 * h + q4) * KROW + 32 * blk + 8 * p4;
    const unsigned koff = r * KROW + 16 * h;
    for (int t = 0; t < U.ntiles; ++t) {
        const int cur = t & 1; const bool more = (t + 1 < U.ntiles);
        if (more) { kreg = *(const u32x4*)(kg + (size_t)(t + 1) * tstride); vreg = *(const u32x4*)(vg + (size_t)(t + 1) * tstride); if (hasb) breg = U.bias[(t + 1) * 64 + tid]; }
        if (active && t <= tlast) {
            const LAS unsigned char* Kt = Kb + cur * TILEB + koff; const LAS unsigned char* Vt = Vb + cur * TILEB + voff; const LAS float* Bt = Bb + cur * 64;
            f32x16 sa, sb;
#pragma unroll
            for (int g = 0; g < 4; ++g) { const f32x4 b0 = *(const LAS f32x4*)(Bt + 8 * g + 4 * h), b1 = *(const LAS f32x4*)(Bt + 32 + 8 * g + 4 * h);
#pragma unroll
                for (int j = 0; j < 4; ++j) { sa[4 * g + j] = b0[j]; sb[4 * g + j] = b1[j]; } }
#pragma unroll
            for (int d0 = 0; d0 < 4; ++d0) { const bf16x8 ka = *(const LAS bf16x8*)(Kt + 32 * d0), kb = *(const LAS bf16x8*)(Kt + 32 * KROW + 32 * d0);
                sa = MFMA32(ka, qf[d0], sa); sb = MFMA32(kb, qf[d0], sb); }
            if (U.causal && 64 * t + 63 > U.qpos0 + 32 * w) {
#pragma unroll
                for (int i = 0; i < 16; ++i) { const int key = 64 * t + crow(i, h); if (key > qpos) sa[i] = -1e30f; if (key + 32 > qpos) sb[i] = -1e30f; }
            }
            float mx = fmaxf(sa[0], sb[0]);
#pragma unroll
            for (int i = 1; i < 16; ++i) mx = fmaxf(mx, fmaxf(sa[i], sb[i]));
            mx = swapmax(mx);
            const float mnew = fmaxf(m, mx), alpha = __builtin_amdgcn_exp2f(m - mnew); m = mnew;
            float ls = 0.f;
#pragma unroll
            for (int i = 0; i < 16; ++i) { sa[i] = __builtin_amdgcn_exp2f(sa[i] - mnew); sb[i] = __builtin_amdgcn_exp2f(sb[i] - mnew); ls += sa[i] + sb[i]; }
            l = l * alpha + ls;
            if (__builtin_amdgcn_ballot_w64(alpha < 1.f) != 0ull) {
#pragma unroll
                for (int i = 0; i < 16; ++i) { o0[i] *= alpha; o1[i] *= alpha; }
            }
            bf16x8 pf[4];
#pragma unroll
            for (int s = 0; s < 2; ++s) {
                u32x4 pa, pb;
                pa.x = pk2(sa[8 * s], sa[8 * s + 1]); pa.y = pk2(sa[8 * s + 2], sa[8 * s + 3]); pa.z = pk2(sa[8 * s + 4], sa[8 * s + 5]); pa.w = pk2(sa[8 * s + 6], sa[8 * s + 7]);
                pb.x = pk2(sb[8 * s], sb[8 * s + 1]); pb.y = pk2(sb[8 * s + 2], sb[8 * s + 3]); pb.z = pk2(sb[8 * s + 4], sb[8 * s + 5]); pb.w = pk2(sb[8 * s + 6], sb[8 * s + 7]);
                pf[s] = __builtin_bit_cast(bf16x8, pa); pf[2 + s] = __builtin_bit_cast(bf16x8, pb);
            }
#pragma unroll
            for (int ks = 0; ks < 4; ++ks) {
#pragma unroll
                for (int db = 0; db < 2; ++db) {
                    const s16x4 lo = vtr(Vt + (16 * ks) * KROW + 64 * db), hi = vtr(Vt + (16 * ks + 8) * KROW + 64 * db);
                    const bf16x8 vf = __builtin_shufflevector(lo, hi, 0, 1, 2, 3, 4, 5, 6, 7);
                    if (db == 0) o0 = MFMA32(vf, pf[ks], o0); else o1 = MFMA32(vf, pf[ks], o1);
                }
            }
        }
        if (more) { const int nb = cur ^ 1; *(LAS u32x4*)(Kb + nb * TILEB + soff) = kreg; *(LAS u32x4*)(Vb + nb * TILEB + soff) = vreg; if (tid < 64) Bb[nb * 64 + tid] = breg; }
        __syncthreads();
    }
    if (active) {
        l = swapsum(l);
        const float inv = 1.0f / l;
        const size_t row = (size_t)(32 * w + r);
        const bf16_t* grow = U.G + row * U.gp; bf16_t* orow = U.O + row * U.op;
#pragma unroll
        for (int db = 0; db < 2; ++db)
#pragma unroll
            for (int g = 0; g < 4; ++g) {
                const int d = 32 * db + 8 * g + 4 * h;
                const u32x2 gv = *(const u32x2*)(grow + d);
                float a0, a1, a2, a3;
                if (db == 0) { a0 = o0[4 * g]; a1 = o0[4 * g + 1]; a2 = o0[4 * g + 2]; a3 = o0[4 * g + 3]; } else { a0 = o1[4 * g]; a1 = o1[4 * g + 1]; a2 = o1[4 * g + 2]; a3 = o1[4 * g + 3]; }
                u32x2 ov; ov.x = pk2(silu_f(bf_lo(gv.x)) * a0 * inv, silu_f(bf_hi(gv.x)) * a1 * inv); ov.y = pk2(silu_f(bf_lo(gv.y)) * a2 * inv, silu_f(bf_hi(gv.y)) * a3 * inv);
                *(u32x2*)(orow + d) = ov;
            }
    }
}

__device__ __forceinline__ void pool_unit(const Params& P, int tt, LAS unsigned char* lds, int tid) {
    asm volatile("" : "+v"(tid));
    const bf16_t* H = (const bf16_t*)(P.ws + WS_H); bf16_t* CAT = (bf16_t*)(P.ws + WS_XN);
    const int R0 = 64 * tt; const bool prompt = R0 < MP; const int s0 = prompt ? (R0 & (SEQ - 1)) : 0;
    LAS float* Ut = (LAS float*)lds;
    LAS bf16_t* Pt = (LAS bf16_t*)(lds + 81920);
    for (int e = tid; e < 79 * 32; e += 512) {
        const int rr = e >> 5, c8 = (e & 31) * 8, sl = rr - 15;
        f32x4 a = {0.f, 0.f, 0.f, 0.f}, c = {0.f, 0.f, 0.f, 0.f};
        if (sl >= 0 || (prompt && s0 + sl >= 0)) {
            const u32x4 hv = *(const u32x4*)(H + (size_t)(R0 + sl) * NH + C_U + c8);
            a = (f32x4){bf_lo(hv.x), bf_hi(hv.x), bf_lo(hv.y), bf_hi(hv.y)}; c = (f32x4){bf_lo(hv.z), bf_hi(hv.z), bf_lo(hv.w), bf_hi(hv.w)};
        } else if (!prompt) {
            const float* sp = P.state_pool + ((size_t)((R0 - MP) >> 6) * 15 + rr) * 256 + c8; a = *(const f32x4*)sp; c = *(const f32x4*)(sp + 4);
        }
        *(LAS f32x4*)(Ut + rr * 256 + c8) = a; *(LAS f32x4*)(Ut + rr * 256 + c8 + 4) = c;
    }
    __syncthreads();
    {
        const int c = tid & 255, half = tid >> 8, g = c >> 6, wn = 2 << g;
        for (int s = half * 32; s < half * 32 + 32; ++s) {
            float sum = 0.f;
            for (int j = 0; j < wn; ++j) sum += Ut[(15 + s - j) * 256 + c];
            const int cnt = prompt ? min(wn, s0 + s + 1) : wn;
            const float pooled = sum / (float)cnt - Ut[(15 + s) * 256 + c];
            Pt[s * 264 + c] = (bf16_t)(pk2(pooled, 0.f) & 0xffffu);
        }
    }
    __syncthreads();
    {
        const int lane = tid & 63, wv = tid >> 6, r = lane & 31, h = lane >> 5, g = wv >> 1, th = wv & 1;
        f32x16 a0, a1;
#pragma unroll
        for (int i = 0; i < 16; ++i) { a0[i] = 0.f; a1[i] = 0.f; }
#pragma unroll
        for (int s = 0; s < 4; ++s) {
            const bf16x8 b = *(const LAS bf16x8*)(Pt + (32 * th + r) * 264 + g * 64 + 16 * s + 8 * h);
            const float* wp = P.w_pool + ((size_t)(g * 64) + 16 * s + 8 * h) * 64 + r;
            u32x4 w0, w1;
            w0.x = pk2(wp[0 * 64], wp[1 * 64]); w0.y = pk2(wp[2 * 64], wp[3 * 64]); w0.z = pk2(wp[4 * 64], wp[5 * 64]); w0.w = pk2(wp[6 * 64], wp[7 * 64]);
            w1.x = pk2(wp[0 * 64 + 32], wp[1 * 64 + 32]); w1.y = pk2(wp[2 * 64 + 32], wp[3 * 64 + 32]); w1.z = pk2(wp[4 * 64 + 32], wp[5 * 64 + 32]); w1.w = pk2(wp[6 * 64 + 32], wp[7 * 64 + 32]);
            a0 = MFMA32(__builtin_bit_cast(bf16x8, w0), b, a0); a1 = MFMA32(__builtin_bit_cast(bf16x8, w1), b, a1);
        }
        const size_t row = (size_t)(R0 + 32 * th + r);
#pragma unroll
        for (int db = 0; db < 2; ++db)
#pragma unroll
            for (int g4 = 0; g4 < 4; ++g4) {
                const int col = g * 64 + 32 * db + 8 * g4 + 4 * h;
                const f32x4 ps = *(const f32x4*)(P.pool_scale + col);
                const u32x2 gv = *(const u32x2*)(H + row * NH + C_GP + col);
                float v0, v1, v2, v3;
                if (db == 0) { v0 = a0[4 * g4]; v1 = a0[4 * g4 + 1]; v2 = a0[4 * g4 + 2]; v3 = a0[4 * g4 + 3]; } else { v0 = a1[4 * g4]; v1 = a1[4 * g4 + 1]; v2 = a1[4 * g4 + 2]; v3 = a1[4 * g4 + 3]; }
                u32x2 ov; ov.x = pk2(silu_f(bf_lo(gv.x)) * v0 * ps.x, silu_f(bf_hi(gv.x)) * v1 * ps.y); ov.y = pk2(silu_f(bf_lo(gv.y)) * v2 * ps.z, silu_f(bf_hi(gv.y)) * v3 * ps.w);
                *(u32x2*)(CAT + row * DM + 512 + col) = ov;
            }
    }
    __syncthreads();
}

constexpr int NU_FOXP = 512, NU_FOXS = 64, NU_MEMP = 256, NU_MEMS = 32, NU_POOL = MTOT / 64;
constexpr int NU_TOTAL = NU_FOXP + NU_FOXS + NU_MEMP + NU_MEMS + NU_POOL;

__device__ __forceinline__ void p2_unit(const Params& P, int idx, LAS unsigned char* lds, int tid) {
    const bf16_t* H = (const bf16_t*)(P.ws + WS_H); bf16_t* CAT = (bf16_t*)(P.ws + WS_XN);
    AUnit U;
    if (idx < NU_FOXP) {
        const int qb = 15 - (idx >> 5), bh = idx & 31, b = bh >> 3, h = bh & 7; const size_t row0 = (size_t)b * SEQ + 256 * qb;
        U.Q = H + row0 * NH + C_Q + h * 64; U.K = H + (size_t)b * SEQ * NH + C_K + h * 64; U.V = H + (size_t)b * SEQ * NH + C_V + h * 64;
        U.bias = (const float*)(P.ws + WS_BIASP) + (size_t)bh * SEQ; U.G = H + row0 * NH + C_GF + h * 64; U.O = CAT + row0 * DM + h * 64;
        U.qp = NH; U.kvp = NH; U.gp = NH; U.op = DM; U.nq = 256; U.ntiles = 4 * qb + 4; U.qpos0 = 256 * qb; U.causal = 1;
    } else if (idx < NU_FOXP + NU_FOXS) {
        const int bh = idx - NU_FOXP, b = bh >> 3, h = bh & 7; const size_t row0 = (size_t)MP + b * DSEQ;
        U.Q = H + row0 * NH + C_Q + h * 64; U.K = (const bf16_t*)(P.ws + WS_KC) + (size_t)b * KTOT * 512 + h * 64; U.V = (const bf16_t*)(P.ws + WS_VC) + (size_t)b * KTOT * 512 + h * 64;
        U.bias = (const float*)(P.ws + WS_BIASS) + (size_t)bh * KTOT; U.G = H + row0 * NH + C_GF + h * 64; U.O = CAT + row0 * DM + h * 64;
        U.qp = NH; U.kvp = 512; U.gp = NH; U.op = DM; U.nq = 64; U.ntiles = KTOT / 64; U.qpos0 = PAST; U.causal = 1;
    } else if (idx < NU_FOXP + NU_FOXS + NU_MEMP) {
        const int i = idx - NU_FOXP - NU_FOXS, qb = i >> 4, b = (i >> 2) & 3, mh = i & 3; const size_t row0 = (size_t)b * SEQ + 256 * qb;
        const bf16_t* MKV = (const bf16_t*)(P.ws + WS_MKV);
        U.Q = H + row0 * NH + C_QM + mh * 64; U.K = MKV + (size_t)b * MEMT * 512 + mh * 64; U.V = U.K + 256;
        U.bias = nullptr; U.G = H + row0 * NH + C_GM + mh * 64; U.O = CAT + row0 * DM + 768 + mh * 64;
        U.qp = NH; U.kvp = 512; U.gp = NH; U.op = DM; U.nq = 256; U.ntiles = 4; U.qpos0 = 0; U.causal = 0;
    } else if (idx < NU_FOXP + NU_FOXS + NU_MEMP + NU_MEMS) {
        const int i = idx - NU_FOXP - NU_FOXS - NU_MEMP, b = i >> 2, mh = i & 3; const size_t row0 = (size_t)MP + b * DSEQ;
        U.Q = H + row0 * NH + C_QM + mh * 64; U.K = (const bf16_t*)(P.ws + WS_CMK) + (size_t)b * MEMT * 256 + mh * 64; U.V = (const bf16_t*)(P.ws + WS_CMV) + (size_t)b * MEMT * 256 + mh * 64;
        U.bias = nullptr; U.G = H + row0 * NH + C_GM + mh * 64; U.O = CAT + row0 * DM + 768 + mh * 64;
        U.qp = NH; U.kvp = 256; U.gp = NH; U.op = DM; U.nq = 64; U.ntiles = 4; U.qpos0 = 0; U.causal = 0;
    } else { pool_unit(P, idx - (NU_FOXP + NU_FOXS + NU_MEMP + NU_MEMS), lds, tid); return; }
    attn_unit(U, lds, tid);
}

__global__ void __launch_bounds__(512, 2) hymba_fwd(Params P) {
    extern __shared__ __attribute__((aligned(16))) unsigned char lds_raw[];
    LAS unsigned char* lds = (LAS unsigned char*)lds_raw;
    cg::grid_group grid = cg::this_grid();
    const int tid = threadIdx.x, G = gridDim.x;
    unsigned char* ws = P.ws;

    p0_prologue(P, lds, tid, G);
    grid.sync();

    for (int sid = G - 1 - (int)blockIdx.x; sid < 96; sid += G) scan_seq(P, sid, lds, tid);
    {
        pg8::Gemm g{(const bf16_t*)(ws + WS_XN), (const bf16_t*)(ws + WS_WIN), MTOT, NH, DM}; pg8::StaticOrder S; S.init(MTOT, NH, G, (int)blockIdx.x);
        pg8::EpiIn E{(bf16_t*)(ws + WS_H), P.out, (bf16_t*)(ws + WS_KC), (bf16_t*)(ws + WS_VC)};
        pg8::gemm_phase<pg8::EpiIn, pg8::StaticOrder, true, true>(lds, g, S, E);
    }
    {
        pg8::Gemm g{(const bf16_t*)(ws + WS_MEMN), (const bf16_t*)(ws + WS_WMEM), MMEM, 512, DM}; pg8::StaticOrder S; S.init(MMEM, 512, G, (int)((blockIdx.x + G - (24 % G)) % G));
        pg8::EpiMem E{(bf16_t*)(ws + WS_MKV), P.out};
        pg8::gemm_phase<pg8::EpiMem, pg8::StaticOrder, true, true>(lds, g, S, E);
    }
    grid.sync();

    {
        unsigned* qhead = (unsigned*)(ws + WS_CTL);
        volatile LAS int* slot = (volatile LAS int*)(lds + LDS_Q);
        for (;;) {
            if (tid == 0) *slot = (int)atomicAdd(qhead, 1u);
            __syncthreads();
            const int idx = *slot;
            __syncthreads();
            if (idx >= NU_TOTAL) break;
            p2_unit(P, idx, lds, tid);
        }
    }
    grid.sync();

    {
        pg8::Gemm g{(const bf16_t*)(ws + WS_XN), (const bf16_t*)(ws + WS_WOUT), MTOT, DM, DM}; pg8::StaticOrder S; S.init(MTOT, DM, G, (int)blockIdx.x);
        pg8::EpiOut E{P.x_prompt, P.x_sample, P.out + O_Y};
        pg8::gemm_phase<pg8::EpiOut, pg8::StaticOrder, true, true>(lds, g, S, E);
    }
    grid.sync();

    {
        int tid4 = tid; asm volatile("" : "+v"(tid4));
        const int lane = tid4 & 63, gw = blockIdx.x * 8 + (tid4 >> 6), NGW = G * 8;
        const f32x4* gr = (const f32x4*)P.g_final + lane;
        for (int m = gw; m < MTOT; m += NGW) {
            f32x4* yr = (f32x4*)(P.out + O_Y + (size_t)m * DM) + lane;
            f32x4 v[4]; float s = 0.f;
#pragma unroll
            for (int j = 0; j < 4; ++j) { v[j] = yr[64 * j]; s += (v[j].x * v[j].x + v[j].y * v[j].y) + (v[j].z * v[j].z + v[j].w * v[j].w); }
            const float rs = 1.0f / sqrtf(wave_sum(s) * (1.f / DM) + EPS);
#pragma unroll
            for (int j = 0; j < 4; ++j) yr[64 * j] = v[j] * rs * gr[64 * j];
        }
    }
}

extern "C" void kernel_launch(void* const* d_in, const int* in_sizes, int n_in, void* d_out, int out_size, void* d_ws, size_t ws_size, hipStream_t stream) {
    static int grid = 0;
    if (grid == 0) {
        int dev = 0, cus = 0, per_cu = 0;
        hipGetDevice(&dev);
        hipDeviceGetAttribute(&cus, hipDeviceAttributeMultiprocessorCount, dev);
        hipFuncSetAttribute((const void*)hymba_fwd, hipFuncAttributeMaxDynamicSharedMemorySize, LDS_BYTES);
        hipOccupancyMaxActiveBlocksPerMultiprocessor(&per_cu, (const void*)hymba_fwd, 512, LDS_BYTES);
        if (per_cu < 1) { fprintf(stderr, "kernel_launch: occupancy query says %d blocks/CU\n", per_cu); per_cu = 1; }
        (void)hipGetLastError();
        grid = cus;
        if (ws_size < WS_END) { fprintf(stderr, "kernel_launch: workspace too small\n"); grid = -1; }
    }
    if (grid < 0) return;
    Params p{};
    p.x_prompt = (const float*)d_in[0]; p.x_sample = (const float*)d_in[1]; p.mem_prompt = (const float*)d_in[2]; p.cache_k = (const float*)d_in[3];
    p.cache_v = (const float*)d_in[4]; p.cache_logf = (const float*)d_in[5]; p.cache_mk = (const float*)d_in[6]; p.cache_mv = (const float*)d_in[7];
    p.state_pool = (const float*)d_in[8]; p.g_norm = (const float*)d_in[9]; p.w_in = (const float*)d_in[10]; p.b_f = (const float*)d_in[11];
    p.w_pool = (const float*)d_in[12]; p.pool_scale = (const float*)d_in[13]; p.g_mem = (const float*)d_in[14]; p.w_mem_kv = (const float*)d_in[15];
    p.w_out = (const float*)d_in[16]; p.g_final = (const float*)d_in[17];
    p.out = (float*)d_out; p.ws = (unsigned char*)d_ws;
    void* args[] = {&p};
    hipError_t e = hipLaunchCooperativeKernel((const void*)hymba_fwd, dim3(grid), dim3(512), args, LDS_BYTES, stream);
    if (e != hipSuccess) fprintf(stderr, "cooperative launch failed: %s (grid %d)\n", hipGetErrorString(e), grid);
}
```

```cpp
#include <hip/hip_runtime.h>
#include <hip/hip_cooperative_groups.h>
#include <cstdio>
#include <cstdint>
namespace cg = cooperative_groups;
#define LAS __attribute__((address_space(3)))
namespace pg8 {
#define PG8_LAS __attribute__((address_space(3)))
typedef unsigned short bf16_t;
typedef short bf16x8 __attribute__((ext_vector_type(8)));
typedef float f32x4 __attribute__((ext_vector_type(4)));
typedef unsigned u32x4 __attribute__((ext_vector_type(4)));
constexpr int BM = 256, BK = 64, HALF = 128, HTB = HALF * BK * 2  , STAGE_BYTES = 8 * HTB, NXCD = 8, WGM = 8;

__host__ __device__ __forceinline__ int lds_byte(int r, int c) { const int st = (r >> 4) * 2 + (c >> 5), rr = r & 15, cc = c & 31, ob = rr * 64 + cc * 2; return st * 1024 + (ob ^ (((ob >> 9) & 1) << 5)); }
__host__ __device__ __forceinline__ void stage_rc(int b, int& R, int& C) { const int st = b / 1024, sb = b % 1024, swz = sb ^ (((sb >> 9) & 1) << 5); R = (st >> 1) * 16 + swz / 64; C = (st & 1) * 32 + (swz % 64) / 2; }
__host__ __device__ __forceinline__ int perm32(int rho) { const int n = rho >> 4, i = rho & 15; return 8 * (i >> 2) + 4 * n + (i & 3); }

struct Unit { int pm, pn; };
struct Gemm { const bf16_t* A; const bf16_t* Bt; int M, N, K; };

struct StaticOrder {
    int nM, nN, nwg, G, c;
    __host__ __device__ void init(int M, int N, int G_, int c_) { nM = M / BM; nN = N / BM; nwg = nM * nN; G = G_; c = c_; }
    __host__ __device__ bool next(int i, Unit& u) const {
        const long L = (long)i * G + c; if (L >= nwg) return false;
        int wgid = (int)L; { const int q = nwg / NXCD, r = nwg % NXCD, xcd = wgid % NXCD, off = wgid / NXCD; wgid = (xcd < r ? xcd * (q + 1) : r * (q + 1) + (xcd - r) * q) + off; }
        const int nig = WGM * nN, gid = wgid / nig, fm = gid * WGM, gsz = (nM - fm) < WGM ? (nM - fm) : WGM;
        u.pm = fm + ((wgid % nig) % gsz); u.pn = (wgid % nig) / gsz; return true;
    }
    __device__ __forceinline__ void a_ready(const Unit&) const {}
    __device__ __forceinline__ void done(const Unit&) const {}
};

__device__ __forceinline__ unsigned cvt_pk_bf16(float lo, float hi) { unsigned r; asm volatile("v_cvt_pk_bf16_f32 %0, %1, %2" : "=v"(r) : "v"(lo), "v"(hi)); return r; }
template <class Epi, class Sched, bool ALIGN_EPI = false, bool SP2 = false>
__device__ __forceinline__ void gemm_phase(PG8_LAS unsigned char* lds, const Gemm g, const Sched& S, const Epi& E) {
    int tid_l = threadIdx.x; asm volatile("" : "+v"(tid_l));
    const int tid = tid_l, wid = __builtin_amdgcn_readfirstlane(tid >> 6), lane = tid & 63, wr = wid >> 2, wc = wid & 3, fr = lane & 15, fq = lane >> 4;
    const int K = g.K, nt = K / BK;
    unsigned voffA[2], voffB[2];
#pragma unroll
    for (int i = 0; i < 2; ++i) { int R, C; stage_rc(tid * 16 + i * 8192, R, C); const int Rb = Epi::PERM ? ((R & ~31) + perm32(R & 31)) : R;
        voffA[i] = (unsigned)(R * K + C) * 2u; voffB[i] = (unsigned)(Rb * K + C) * 2u; }
    const size_t kstep = (size_t)(BK * 2);
    const size_t hstep = (size_t)HALF * K * 2;
    const size_t tstep = 2 * hstep;
    const unsigned ldsw = (unsigned)wid * 1024u;
    const int aoff = lds_byte(wr * 64 + fr, fq * 8), boff = lds_byte(wc * 32 + fr, fq * 8);
#define PG8_SA(b, h) (((b) * 2 + (h)) * HTB)
#define PG8_SB(b, h) ((4 + (b) * 2 + (h)) * HTB)
#define PG8_STAGE(bufoff, gbase, voff) do { _Pragma("unroll") for (int _i = 0; _i < 2; ++_i) \
        __builtin_amdgcn_global_load_lds((const unsigned*)((const char*)(gbase) + (voff)[_i]), (PG8_LAS unsigned*)(lds + (bufoff) + ldsw + _i * 8192), 16, 0, 0); } while (0)
#define PG8_LDA(dst, b, h) do { _Pragma("unroll") for (int m = 0; m < 4; ++m) _Pragma("unroll") for (int k = 0; k < 2; ++k) dst[m][k] = *(const PG8_LAS bf16x8*)(lds + PG8_SA(b, h) + aoff + m * 2048 + k * 1024); } while (0)
#define PG8_LDB(dst, b, h) do { _Pragma("unroll") for (int n = 0; n < 2; ++n) _Pragma("unroll") for (int k = 0; k < 2; ++k) dst[n][k] = *(const PG8_LAS bf16x8*)(lds + PG8_SB(b, h) + boff + n * 2048 + k * 1024); } while (0)
#define PG8_MMA(ai, bj, At, Bt) do { __builtin_amdgcn_s_setprio(1); _Pragma("unroll") for (int m = 0; m < 4; ++m) _Pragma("unroll") for (int n = 0; n < 2; ++n) _Pragma("unroll") for (int k = 0; k < 2; ++k) \
        acc[ai][bj][m][n] = __builtin_amdgcn_mfma_f32_16x16x32_bf16(Bt[n][k], At[m][k], acc[ai][bj][m][n], 0, 0, 0); __builtin_amdgcn_s_setprio(0); } while (0)
#define PG8_WAIT_V(n) asm volatile("s_waitcnt vmcnt(" #n ")" ::: "memory")
#define PG8_WAIT_L(n) asm volatile("s_waitcnt lgkmcnt(" #n ")" ::: "memory")
#define PG8_BAR __builtin_amdgcn_s_barrier()
#define PG8_SCHED __builtin_amdgcn_sched_barrier(0)
    Unit cur, nxt; int ui = 0;
    if (!S.next(0, cur)) return;
    f32x4 acc[2][2][4][2];
#pragma unroll
    for (int a = 0; a < 2; ++a)
#pragma unroll
        for (int b = 0; b < 2; ++b)
#pragma unroll
            for (int m = 0; m < 4; ++m)
#pragma unroll
                for (int n = 0; n < 2; ++n) acc[a][b][m][n] = (f32x4){0.f, 0.f, 0.f, 0.f};
    bf16x8 At[4][2], B0[2][2], B1[2][2];
    const char* cA = (const char*)g.A + (size_t)cur.pm * tstep; const char* cB = (const char*)g.Bt + (size_t)cur.pn * tstep;
    S.a_ready(cur);
    if constexpr (SP2) {
        PG8_STAGE(PG8_SB(0, 0), cB, voffB); PG8_STAGE(PG8_SB(0, 1), cB + hstep, voffB); PG8_STAGE(PG8_SA(0, 0), cA, voffA); PG8_STAGE(PG8_SA(0, 1), cA + hstep, voffA);
        if (wr == 1) PG8_BAR;
        PG8_WAIT_V(2); PG8_BAR;
        PG8_STAGE(PG8_SB(1, 0), cB + kstep, voffB); PG8_STAGE(PG8_SA(1, 0), cA + kstep, voffA); PG8_STAGE(PG8_SB(1, 1), cB + hstep + kstep, voffB);
        PG8_WAIT_V(6); PG8_BAR;
    } else {
        PG8_STAGE(PG8_SB(0, 0), cB, voffB); PG8_STAGE(PG8_SA(0, 0), cA, voffA); PG8_STAGE(PG8_SB(0, 1), cB + hstep, voffB); PG8_STAGE(PG8_SA(0, 1), cA + hstep, voffA);
        if (wr == 1) PG8_BAR;
        PG8_WAIT_V(4); PG8_BAR;
        PG8_STAGE(PG8_SB(1, 0), cB + kstep, voffB); PG8_STAGE(PG8_SA(1, 0), cA + kstep, voffA); PG8_STAGE(PG8_SB(1, 1), cB + hstep + kstep, voffB);
        PG8_WAIT_V(6); PG8_BAR;
    }
    for (;;) {
        const bool has_next = S.next(ui + 1, nxt);
        const char* nA = has_next ? (const char*)g.A + (size_t)nxt.pm * tstep : cA; const char* nB = has_next ? (const char*)g.Bt + (size_t)nxt.pn * tstep : cB;
        for (int t = 0; t < nt; t += 2) {
            const bool last = (t == nt - 2);
            const char* a1 = cA + (size_t)(t + 1) * kstep;
            const char* a2 = last ? nA : cA + (size_t)(t + 2) * kstep; const char* b2 = last ? nB : cB + (size_t)(t + 2) * kstep;
            const char* a3 = a2 + kstep; const char* b3 = b2 + kstep;
            if (last && has_next) S.a_ready(nxt);
            if constexpr (SP2) {
            PG8_LDB(B0, 0, 0); PG8_LDB(B1, 0, 1); PG8_SCHED; PG8_LDA(At, 0, 0); PG8_STAGE(PG8_SA(1, 1), a1 + hstep, voffA);
            PG8_WAIT_V(8); PG8_WAIT_L(0); PG8_BAR; PG8_MMA(0, 0, At, B0); PG8_MMA(0, 1, At, B1); PG8_BAR; PG8_SCHED;
            PG8_LDA(At, 0, 1); PG8_STAGE(PG8_SB(0, 0), b2, voffB); PG8_STAGE(PG8_SB(0, 1), b2 + hstep, voffB); PG8_STAGE(PG8_SA(0, 0), a2, voffA);
            PG8_WAIT_V(8); PG8_WAIT_L(0); PG8_BAR; PG8_MMA(1, 0, At, B0); PG8_MMA(1, 1, At, B1); PG8_BAR; PG8_SCHED;
            PG8_LDB(B0, 1, 0); PG8_LDB(B1, 1, 1); PG8_SCHED; PG8_LDA(At, 1, 0); PG8_STAGE(PG8_SA(0, 1), a2 + hstep, voffA);
            PG8_WAIT_V(8); PG8_WAIT_L(0); PG8_BAR; PG8_MMA(0, 0, At, B0); PG8_MMA(0, 1, At, B1); PG8_BAR; PG8_SCHED;
            PG8_LDA(At, 1, 1); PG8_STAGE(PG8_SB(1, 0), b3, voffB); PG8_STAGE(PG8_SB(1, 1), b3 + hstep, voffB); PG8_STAGE(PG8_SA(1, 0), a3, voffA);
            PG8_WAIT_V(8); PG8_WAIT_L(0); PG8_BAR; PG8_MMA(1, 0, At, B0); PG8_MMA(1, 1, At, B1); PG8_BAR; PG8_SCHED;
            } else {
            PG8_LDB(B0, 0, 0); PG8_SCHED; PG8_LDA(At, 0, 0); PG8_STAGE(PG8_SA(1, 1), a1 + hstep, voffA);
            PG8_WAIT_L(8); PG8_BAR; PG8_WAIT_L(0); PG8_MMA(0, 0, At, B0); PG8_BAR; PG8_SCHED;
            PG8_LDB(B1, 0, 1); PG8_STAGE(PG8_SB(0, 0), b2, voffB);
            PG8_BAR; PG8_WAIT_L(0); PG8_MMA(0, 1, At, B1); PG8_BAR;
            PG8_LDA(At, 0, 1); PG8_STAGE(PG8_SA(0, 0), a2, voffA);
            PG8_BAR; PG8_WAIT_L(0); PG8_MMA(1, 0, At, B0); PG8_BAR; PG8_SCHED;
            PG8_STAGE(PG8_SB(0, 1), b2 + hstep, voffB);
            PG8_WAIT_V(6); PG8_BAR; PG8_MMA(1, 1, At, B1); PG8_BAR;
            PG8_LDB(B0, 1, 0); PG8_SCHED; PG8_LDA(At, 1, 0); PG8_STAGE(PG8_SA(0, 1), a2 + hstep, voffA);
            PG8_WAIT_L(8); PG8_BAR; PG8_WAIT_L(0); PG8_MMA(0, 0, At, B0); PG8_BAR; PG8_SCHED;
            PG8_LDB(B1, 1, 1); PG8_STAGE(PG8_SB(1, 0), b3, voffB);
            PG8_BAR; PG8_WAIT_L(0); PG8_MMA(0, 1, At, B1); PG8_BAR;
            PG8_LDA(At, 1, 1); PG8_STAGE(PG8_SA(1, 0), a3, voffA);
            PG8_BAR; PG8_WAIT_L(0); PG8_MMA(1, 0, At, B0); PG8_BAR; PG8_SCHED;
            PG8_STAGE(PG8_SB(1, 1), b3 + hstep, voffB);
            PG8_WAIT_V(6); PG8_BAR; PG8_MMA(1, 1, At, B1); PG8_BAR;
            }
        }
        if constexpr (ALIGN_EPI) { if (wr == 0) PG8_BAR; }
        if constexpr (!Epi::AFTER_DRAIN) { E(acc, cur, wr, wc, fr, fq); S.done(cur); }
        if (!has_next) break;
#pragma unroll
        for (int a = 0; a < 2; ++a)
#pragma unroll
            for (int b = 0; b < 2; ++b)
#pragma unroll
                for (int m = 0; m < 4; ++m)
#pragma unroll
                    for (int n = 0; n < 2; ++n) acc[a][b][m][n] = (f32x4){0.f, 0.f, 0.f, 0.f};
        cur = nxt; cA = nA; cB = nB; ++ui;
        if constexpr (ALIGN_EPI) { if (wr == 1) PG8_BAR; }
    }
    PG8_WAIT_V(0);
    if constexpr (!ALIGN_EPI) { if (wr == 0) PG8_BAR; }
    PG8_BAR;
    if constexpr (Epi::AFTER_DRAIN) { E.fused(acc, cur, wr, wc, fr, fq, lds, wid, lane); S.done(cur); }
#undef PG8_SA
#undef PG8_SB
#undef PG8_STAGE
#undef PG8_LDA
#undef PG8_LDB
#undef PG8_MMA
#undef PG8_WAIT_V
#undef PG8_WAIT_L
#undef PG8_BAR
#undef PG8_SCHED
}
}
#define XB_TMO      128
#define XB_XCNT(j)  (256  + 64 * (j))
#define XB_XSUB(j)  (1280 + 64 * (j))
#define XB_XGEN(j)  (2304 + 64 * (j))
#define XB_TOP      3328
#define XB_TOPGEN   3392
#define XCD_BAR_WORDS 3456
#define XB_SPIN_CAP (1u << 18)

__device__ __forceinline__ unsigned xb_ld(unsigned* p)              { return __hip_atomic_load(p, __ATOMIC_RELAXED, __HIP_MEMORY_SCOPE_AGENT); }
__device__ __forceinline__ unsigned xb_add(unsigned* p, unsigned v) { return __hip_atomic_fetch_add(p, v, __ATOMIC_RELAXED, __HIP_MEMORY_SCOPE_AGENT); }
__device__ __forceinline__ unsigned xb_xcc_id() { return (unsigned)__builtin_amdgcn_s_getreg((3 << 11) | 20) & 0xFu; }
#define XB_SPIN(cond, bar) do { unsigned _sp = 0; while (cond) { __builtin_amdgcn_s_sleep(1); \
    if ((++_sp & 255u) == 0u) { if (xb_ld(&(bar)[XB_TMO])) break; if (_sp > XB_SPIN_CAP) { atomicAdd(&(bar)[XB_TMO], 1u); break; } } } } while (0)

struct XcdBarrier {
    unsigned* bar; unsigned x;
    volatile LAS unsigned* st;
};

__device__ __forceinline__ XcdBarrier xcd_barrier_post(unsigned* bar, volatile LAS unsigned* st) {
    XcdBarrier b; b.bar = bar; b.x = xb_xcc_id(); b.st = st;
    if (threadIdx.x == 0) (void)xb_add(&bar[XB_XCNT(b.x)], 1u);
    return b;
}
__device__ __forceinline__ void xcd_barrier_complete(unsigned* bar, unsigned x, unsigned& nloc, unsigned& nx) {
    const unsigned G = gridDim.x * gridDim.y * gridDim.z;
    unsigned sum, cnt, mine, sp = 0u;
    for (;;) {
        sum = 0u; cnt = 0u; mine = 0u;
#pragma unroll
        for (unsigned j = 0; j < 16; ++j) { const unsigned c = xb_ld(&bar[XB_XCNT(j)]); sum += c; cnt += (c > 0u) ? 1u : 0u; mine = (j == x) ? c : mine; }
        if (sum == G) break;
        __builtin_amdgcn_s_sleep(1);
        if ((++sp & 255u) == 0u) { if (xb_ld(&bar[XB_TMO])) break; if (sp > XB_SPIN_CAP) { atomicAdd(&bar[XB_TMO], 1u); break; } }
    }
    nloc = mine > 0u ? mine : 1u; nx = cnt > 0u ? cnt : 1u;
}

__device__ __forceinline__ void xcd_barrier(const XcdBarrier& b) {
    asm volatile("s_waitcnt vmcnt(0)" ::: "memory");
    __syncthreads();
    if (threadIdx.x == 0) {
        unsigned* bar = b.bar;
        __builtin_amdgcn_s_waitcnt(0);
        unsigned nloc = b.st[0], nx = b.st[1];
        if (nloc == 0u) { xcd_barrier_complete(bar, b.x, nloc, nx); b.st[0] = nloc; b.st[1] = nx; }
        const unsigned old = xb_add(&bar[XB_XSUB(b.x)], 1u);
        const unsigned gen = old / nloc;
        if (old + 1u == (gen + 1u) * nloc) {
            __builtin_amdgcn_fence(__ATOMIC_RELEASE, "agent");
            asm volatile("s_waitcnt vmcnt(0)" ::: "memory");
            const unsigned og = xb_add(&bar[XB_TOP], 1u);
            const unsigned tg = og / nx;
            if (og + 1u == (tg + 1u) * nx) xb_add(&bar[XB_TOPGEN], 1u);
            else XB_SPIN(xb_ld(&bar[XB_TOPGEN]) == tg, bar);
            __builtin_amdgcn_fence(__ATOMIC_ACQUIRE, "agent");
            xb_add(&bar[XB_XGEN(b.x)], 1u);
            asm volatile("s_waitcnt vmcnt(0)" ::: "memory");
        } else {
            XB_SPIN(xb_ld(&bar[XB_XGEN(b.x)]) == gen, bar);
            __builtin_amdgcn_fence(__ATOMIC_ACQUIRE, "agent");
            asm volatile("s_waitcnt vmcnt(0)" ::: "memory");
        }
    }
    __syncthreads();
}

#define LAS __attribute__((address_space(3)))
typedef unsigned short bf16_t;
typedef float f32x4 __attribute__((ext_vector_type(4)));
typedef float f32x16 __attribute__((ext_vector_type(16)));
typedef short bf16x8 __attribute__((ext_vector_type(8)));
typedef short s16x4 __attribute__((ext_vector_type(4)));
typedef unsigned u32x4 __attribute__((ext_vector_type(4)));
typedef unsigned u32x2 __attribute__((ext_vector_type(2)));
typedef float f32x2_t __attribute__((ext_vector_type(2)));
typedef __bf16 bf16x2_t __attribute__((ext_vector_type(2)));

constexpr int DM = 1024, NB = 4, SEQ = 4096, DB = 8, DSEQ = 64, PAST = 2048, KTOT = PAST + DSEQ;
constexpr int FH = 8, HD = 64, MHEADS = 4, MEMT = 256, DIN = 3080;
constexpr int MP = NB * SEQ, MS = DB * DSEQ, MTOT = MP + MS, MMEM = NB * MEMT;
constexpr int NH = 3072;
constexpr int C_Q = 0, C_K = 512, C_V = 1024, C_GF = 1536, C_U = 2048, C_GP = 2304, C_QM = 2560, C_GM = 2816;
constexpr float EPS = 1e-6f, LOG2E = 1.4426950408889634f, C2 = 0.125f * LOG2E;
constexpr size_t O_Y = 0, O_K_P = 17301504, O_V_P = 25690112, O_LF_P = 34078720, O_MK_P = 34209792, O_MV_P = 34471936,
                 O_POOL_P = 34734080, O_K_S = 34749440, O_V_S = 35011584, O_LF_S = 35273728, O_POOL_S = 35277824;
constexpr size_t MiB = 1u << 20;
constexpr size_t WS_CTL = 0, WS_WIN = 1 * MiB, WS_WMEM = 7 * MiB, WS_WOUT = 8 * MiB, WS_MEMN = 10 * MiB, WS_MKV = 12 * MiB, WS_CMK = 13 * MiB,
                 WS_CMV = 14 * MiB, WS_BIASP = 15 * MiB, WS_BIASS = 16 * MiB, WS_KC = 17 * MiB, WS_VC = 34 * MiB, WS_XN = 51 * MiB, WS_H = 84 * MiB,
                 WS_END = 183 * MiB;
constexpr int LDS_BYTES = 147456;
constexpr int LDS_Q = 140000;
constexpr int LDS_MISC = 140032;
constexpr int CW_BAR = 4096;
constexpr size_t CTL_ZERO_BYTES = 65536;

struct Params {
    const float *x_prompt, *x_sample, *mem_prompt, *cache_k, *cache_v, *cache_logf, *cache_mk, *cache_mv, *state_pool;
    const float *g_norm, *w_in, *b_f, *w_pool, *pool_scale, *g_mem, *w_mem_kv, *w_out, *g_final;
    float* out; unsigned char* ws;
};

__device__ __forceinline__ unsigned pk2(float lo, float hi) { f32x2_t v = {lo, hi}; bf16x2_t b = __builtin_convertvector(v, bf16x2_t); return __builtin_bit_cast(unsigned, b); }
__device__ __forceinline__ float bf_lo(unsigned u) { return __uint_as_float(u << 16); }
__device__ __forceinline__ float bf_hi(unsigned u) { return __uint_as_float(u & 0xffff0000u); }
__device__ __forceinline__ float wave_sum(float v) {
#pragma unroll
    for (int o = 1; o < 64; o <<= 1) v += __shfl_xor(v, o);
    return v;
}
__device__ __forceinline__ float silu_f(float x) { return x * __builtin_amdgcn_rcpf(1.f + __expf(-x)); }
__device__ __forceinline__ int crow(int r, int hi) { return (r & 3) + 8 * (r >> 2) + 4 * hi; }
#define MFMA32(a, b, c) __builtin_amdgcn_mfma_f32_32x32x16_bf16((a), (b), (c), 0, 0, 0)

namespace pg8 {
struct EpiIn {
    static constexpr bool PERM = true, AFTER_DRAIN = false;
    bf16_t* H; float* out; bf16_t* KC; bf16_t* VC;
    __device__ __forceinline__ void operator()(const f32x4 (&acc)[2][2][4][2], const Unit& u, int wr, int wc, int fr, int fq) const {
        const int pn = u.pn;
        const float sc = (pn < 2 || pn == 10) ? C2 : 1.f;
        const int row0 = u.pm * BM + wr * 64 + fr, colb = pn * BM + wc * 32 + 8 * fq;
#pragma unroll
        for (int ai = 0; ai < 2; ++ai)
#pragma unroll
            for (int m = 0; m < 4; ++m) {
                const int row = row0 + ai * HALF + m * 16;
#pragma unroll
                for (int bj = 0; bj < 2; ++bj) {
                    const int col = colb + bj * HALF;
                    const f32x4 v0 = acc[ai][bj][m][0], v1 = acc[ai][bj][m][1];
                    u32x4 w; w.x = pk2(v0[0] * sc, v0[1] * sc); w.y = pk2(v0[2] * sc, v0[3] * sc); w.z = pk2(v1[0] * sc, v1[1] * sc); w.w = pk2(v1[2] * sc, v1[3] * sc);
                    *(u32x4*)(H + (size_t)row * NH + col) = w;
                    if (pn >= 2 && pn < 6) {
                        const bool isv = pn >= 4; const int c = col - (isv ? C_V : C_K);
                        float* dst;
                        if (row < MP) dst = out + (isv ? O_V_P : O_K_P) + (size_t)row * 512 + c;
                        else { const int rs = row - MP; dst = out + (isv ? O_V_S : O_K_S) + (size_t)rs * 512 + c;
                               bf16_t* cd = (isv ? VC : KC) + ((size_t)(rs >> 6) * KTOT + PAST + (rs & 63)) * 512 + c; *(u32x4*)cd = w; }
                        *(f32x4*)dst = v0; *(f32x4*)(dst + 4) = v1;
                    } else if (pn == 8) {
                        const int c = col - C_U; float* dst = nullptr;
                        if (row < MP) { const int s = row & (SEQ - 1); if (s >= SEQ - 15) dst = out + O_POOL_P + ((size_t)(row >> 12) * 15 + (s - (SEQ - 15))) * 256 + c; }
                        else { const int rs = row - MP, s = rs & 63; if (s >= DSEQ - 15) dst = out + O_POOL_S + ((size_t)(rs >> 6) * 15 + (s - (DSEQ - 15))) * 256 + c; }
                        if (dst) { *(f32x4*)dst = v0; *(f32x4*)(dst + 4) = v1; }
                    }
                }
            }
    }
};
struct EpiMem {
    static constexpr bool PERM = true, AFTER_DRAIN = false;
    bf16_t* MKV; float* out;
    __device__ __forceinline__ void operator()(const f32x4 (&acc)[2][2][4][2], const Unit& u, int wr, int wc, int fr, int fq) const {
        const int row0 = u.pm * BM + wr * 64 + fr, colb = u.pn * BM + wc * 32 + 8 * fq;
        float* ob = out + (u.pn ? O_MV_P : O_MK_P);
#pragma unroll
        for (int ai = 0; ai < 2; ++ai)
#pragma unroll
            for (int m = 0; m < 4; ++m) {
                const int row = row0 + ai * HALF + m * 16;
#pragma unroll
                for (int bj = 0; bj < 2; ++bj) {
                    const int col = colb + bj * HALF;
                    const f32x4 v0 = acc[ai][bj][m][0], v1 = acc[ai][bj][m][1];
                    u32x4 w; w.x = pk2(v0[0], v0[1]); w.y = pk2(v0[2], v0[3]); w.z = pk2(v1[0], v1[1]); w.w = pk2(v1[2], v1[3]);
                    *(u32x4*)(MKV + (size_t)row * 512 + col) = w;
                    float* dst = ob + (size_t)row * 256 + (col - u.pn * BM);
                    *(f32x4*)dst = v0; *(f32x4*)(dst + 4) = v1;
                }
            }
    }
};
struct EpiOut {
    static constexpr bool PERM = false, AFTER_DRAIN = false;
    const float* xp; const float* xs; float* y;
    __device__ __forceinline__ void operator()(const f32x4 (&acc)[2][2][4][2], const Unit& u, int wr, int wc, int fr, int fq) const {
        const int row0 = u.pm * BM + wr * 64 + fr, colb = u.pn * BM + wc * 32 + 4 * fq;
        const float* xb = (u.pm * BM < MP) ? xp : (xs - (size_t)MP * DM);
#pragma unroll
        for (int ai = 0; ai < 2; ++ai)
#pragma unroll
            for (int m = 0; m < 4; ++m) {
                const size_t off = (size_t)(row0 + ai * HALF + m * 16) * DM + colb;
#pragma unroll
                for (int bj = 0; bj < 2; ++bj)
#pragma unroll
                    for (int n = 0; n < 2; ++n) {
                        const f32x4 xv = *(const f32x4*)(xb + off + bj * HALF + n * 16);
                        *(f32x4*)(y + off + bj * HALF + n * 16) = xv + acc[ai][bj][m][n];
                    }
            }
    }
};
}

__device__ __forceinline__ void transpose_item(const float* W, int pitch, int src_col0, bf16_t* WT, int K, int dst_row0, int k0, LAS float* scr, int lane) {
#pragma unroll 8
    for (int i = 0; i < 32; ++i) { const int kk = 2 * i + (lane >> 5); scr[kk * 33 + (lane & 31)] = W[(size_t)(k0 + kk) * pitch + src_col0 + (lane & 31)]; }
    asm volatile("s_waitcnt lgkmcnt(0)" ::: "memory");
    const int c = lane & 7;
#pragma unroll
    for (int j = 0; j < 4; ++j) { const int n = (lane >> 3) + 8 * j; const LAS float* s = scr + (8 * c) * 33 + n;
        u32x4 o; o.x = pk2(s[0 * 33], s[1 * 33]); o.y = pk2(s[2 * 33], s[3 * 33]); o.z = pk2(s[4 * 33], s[5 * 33]); o.w = pk2(s[6 * 33], s[7 * 33]);
        *(u32x4*)(WT + (size_t)(dst_row0 + n) * K + k0 + 8 * c) = o; }
    asm volatile("s_waitcnt lgkmcnt(0)" ::: "memory");
}

__device__ __forceinline__ float log_sigmoid_f(float t) { return fminf(t, 0.f) - log1pf(__expf(-fabsf(t))); }

template <bool ZF>
__device__ __forceinline__ void norm_row(const float* xrow, const float* g, bf16_t* orow, int lane, const LAS float* wz, const float* bfv, float* lf_out) {
    const f32x4* xr = (const f32x4*)xrow + lane; const f32x4* gr = (const f32x4*)g + lane;
    f32x4 v[4]; float s = 0.f;
#pragma unroll
    for (int j = 0; j < 4; ++j) { v[j] = xr[64 * j]; s += (v[j].x * v[j].x + v[j].y * v[j].y) + (v[j].z * v[j].z + v[j].w * v[j].w); }
    const float rs = 1.0f / sqrtf(wave_sum(s) * (1.f / DM) + EPS);
    unsigned long long* o8 = (unsigned long long*)orow + lane;
#pragma unroll
    for (int j = 0; j < 4; ++j) { const f32x4 gv = gr[64 * j]; v[j] = v[j] * rs * gv;
        o8[64 * j] = (unsigned long long)pk2(v[j].x, v[j].y) | ((unsigned long long)pk2(v[j].z, v[j].w) << 32); }
    if (ZF) {
        float z[8];
#pragma unroll
        for (int hh = 0; hh < 8; ++hh) { float a = 0.f;
#pragma unroll
            for (int j = 0; j < 4; ++j) { const f32x4 w = *(const LAS f32x4*)(wz + hh * DM + 4 * (lane + 64 * j)); a += (v[j].x * w.x + v[j].y * w.y) + (v[j].z * w.z + v[j].w * w.w); }
            z[hh] = wave_sum(a); }
        float zz = z[0];
#pragma unroll
        for (int hh = 1; hh < 8; ++hh) zz = (lane == hh) ? z[hh] : zz;
        if (lane < 8) lf_out[lane] = log_sigmoid_f(zz + bfv[lane]);
    }
}

__device__ __forceinline__ void p0_prologue(const Params& P, LAS unsigned char* lds, int tid, int G) {
    asm volatile("" : "+v"(tid));
    const int lane = tid & 63, wave = tid >> 6;
    unsigned char* ws = P.ws;
    bf16_t* WIN = (bf16_t*)(ws + WS_WIN); bf16_t* WMEM = (bf16_t*)(ws + WS_WMEM); bf16_t* WOUT = (bf16_t*)(ws + WS_WOUT);
    bf16_t* XN = (bf16_t*)(ws + WS_XN); bf16_t* MEMN = (bf16_t*)(ws + WS_MEMN);
    LAS float* wz = (LAS float*)(lds + 73728);
    for (int e = tid; e < 8 * DM; e += 512) { const int k = e >> 3, j = e & 7; wz[j * DM + k] = P.w_in[(size_t)k * DIN + 2048 + j]; }
    LAS float* scr = (LAS float*)(lds + wave * 8704);
    const int gw = blockIdx.x * 8 + wave, NGW = G * 8;
    constexpr int I_IN = 16 * 96, I_MEM = 16 * 16, I_OUT = 16 * 32;
    for (int it = gw; it < I_IN + I_MEM + I_OUT; it += NGW) {
        int r = it;
        if (r < I_IN) { const int kb = r / 96, nb = r % 96, n0 = 32 * nb; transpose_item(P.w_in, DIN, n0 < 2048 ? n0 : n0 + 8, WIN, DM, n0, 64 * kb, scr, lane); continue; }
        r -= I_IN;
        if (r < I_MEM) { const int kb = r / 16, nb = r % 16; transpose_item(P.w_mem_kv, 512, 32 * nb, WMEM, DM, 32 * nb, 64 * kb, scr, lane); continue; }
        r -= I_MEM;
        { const int kb = r / 32, nb = r % 32; transpose_item(P.w_out, DM, 32 * nb, WOUT, DM, 32 * nb, 64 * kb, scr, lane); }
    }
    __syncthreads();
    for (int m = gw; m < MTOT + MMEM; m += NGW) {
        if (m < MP) norm_row<true>(P.x_prompt + (size_t)m * DM, P.g_norm, XN + (size_t)m * DM, lane, wz, P.b_f, P.out + O_LF_P + (size_t)m * 8);
        else if (m < MTOT) norm_row<true>(P.x_sample + (size_t)(m - MP) * DM, P.g_norm, XN + (size_t)m * DM, lane, wz, P.b_f, P.out + O_LF_S + (size_t)(m - MP) * 8);
        else norm_row<false>(P.mem_prompt + (size_t)(m - MTOT) * DM, P.g_mem, MEMN + (size_t)(m - MTOT) * DM, lane, wz, nullptr, nullptr);
    }
    const int gt = blockIdx.x * 512 + tid, NGT = G * 512;
    bf16_t* KC = (bf16_t*)(ws + WS_KC); bf16_t* VC = (bf16_t*)(ws + WS_VC); bf16_t* CMK = (bf16_t*)(ws + WS_CMK); bf16_t* CMV = (bf16_t*)(ws + WS_CMV);
    constexpr int PER_B = PAST * 512, NCK = DB * PER_B / 8;
    for (int i = gt; i < 2 * NCK; i += NGT) {
        const bool isv = i >= NCK; const int i8 = (isv ? i - NCK : i) * 8; const int b = i8 / PER_B, within = i8 - b * PER_B;
        const float* src = (isv ? P.cache_v : P.cache_k) + i8;
        const f32x4 a = *(const f32x4*)src, c = *(const f32x4*)(src + 4);
        u32x4 w; w.x = pk2(a.x, a.y); w.y = pk2(a.z, a.w); w.z = pk2(c.x, c.y); w.w = pk2(c.z, c.w);
        *(u32x4*)((isv ? VC : KC) + (size_t)b * KTOT * 512 + within) = w;
    }
    constexpr int NCM = DB * MEMT * 256 / 8;
    for (int i = gt; i < 2 * NCM; i += NGT) {
        const bool isv = i >= NCM; const int i8 = (isv ? i - NCM : i) * 8;
        const float* src = (isv ? P.cache_mv : P.cache_mk) + i8;
        const f32x4 a = *(const f32x4*)src, c = *(const f32x4*)(src + 4);
        u32x4 w; w.x = pk2(a.x, a.y); w.y = pk2(a.z, a.w); w.z = pk2(c.x, c.y); w.w = pk2(c.z, c.w);
        *(u32x4*)((isv ? CMV : CMK) + i8) = w;
    }
}

__device__ __forceinline__ void scan_seq(const Params& P, int sid, LAS unsigned char* lds, int tid) {
    asm volatile("" : "+v"(tid));
    const int lane = tid & 63, wave = tid >> 6;
    LAS float* wt = (LAS float*)lds;
    int L; float* dst; const float* src0; const float* src1; int split;
    if (sid < 32) { const int b = sid >> 3, h = sid & 7; L = SEQ; split = SEQ; src0 = P.out + O_LF_P + (size_t)b * SEQ * 8 + h; src1 = src0; dst = (float*)(P.ws + WS_BIASP) + (size_t)sid * SEQ; }
    else { const int s2 = sid - 32, b = s2 >> 3, h = s2 & 7; L = KTOT; split = PAST; src0 = P.cache_logf + (size_t)b * PAST * 8 + h;
           src1 = P.out + O_LF_S + (size_t)b * DSEQ * 8 + h - (size_t)PAST * 8; dst = (float*)(P.ws + WS_BIASS) + (size_t)s2 * KTOT; }
    float v[8]; float run = 0.f;
#pragma unroll
    for (int j = 0; j < 8; ++j) { const int pos = tid * 8 + j; float x = 0.f; if (pos < L) x = (pos < split) ? src0[(size_t)pos * 8] : src1[(size_t)pos * 8]; run += x; v[j] = run; }
    float inc = run;
#pragma unroll
    for (int o = 1; o < 64; o <<= 1) { const float t = __shfl_up(inc, o); if (lane >= o) inc += t; }
    if (lane == 63) wt[wave] = inc;
    __syncthreads();
    float base = inc - run;
    for (int w = 0; w < wave; ++w) base += wt[w];
#pragma unroll
    for (int j = 0; j < 8; ++j) { const int pos = tid * 8 + j; if (pos < L) dst[pos] = -(base + v[j]) * LOG2E; }
    __syncthreads();
}

struct AUnit { const bf16_t* Q; const bf16_t* K; const bf16_t* V; const float* bias; const bf16_t* G; bf16_t* O; int qp, kvp, gp, op, nq, ntiles, qpos0, causal; };

__device__ __forceinline__ s16x4 vtr(const LAS unsigned char* p) {
    typedef short v4i16_t __attribute__((ext_vector_type(4)));
    return __builtin_bit_cast(s16x4, __builtin_amdgcn_ds_read_tr16_b64_v4i16((LAS v4i16_t*)p));
}
__device__ __forceinline__ float swapmax(float m) { auto rr = __builtin_amdgcn_permlane32_swap(__float_as_uint(m), __float_as_uint(m), false, false); return fmaxf(__uint_as_float(rr[0]), __uint_as_float(rr[1])); }
__device__ __forceinline__ float swapsum(float m) { auto rr = __builtin_amdgcn_permlane32_swap(__float_as_uint(m), __float_as_uint(m), false, false); return __uint_as_float(rr[0]) + __uint_as_float(rr[1]); }

__device__ __forceinline__ void attn_unit(const AUnit& U, LAS unsigned char* lds, int tid) {
    asm volatile("" : "+v"(tid));
    constexpr int KROW = 144, TILEB = 64 * KROW;
    const int lane = tid & 63, w = __builtin_amdgcn_readfirstlane(tid >> 6), r = lane & 31, h = lane >> 5;
    LAS unsigned char* Kb = lds; LAS unsigned char* Vb = lds + 2 * TILEB; LAS float* Bb = (LAS float*)(lds + 4 * TILEB);
    const bool active = (32 * w < U.nq);
    const int skey = tid >> 3, sch = tid & 7;
    const bf16_t* kg = U.K + (size_t)skey * U.kvp + sch * 8;
    const bf16_t* vg = U.V + (size_t)skey * U.kvp + sch * 8;
    const unsigned soff = skey * KROW + sch * 16;
    const size_t tstride = (size_t)64 * U.kvp;
    bf16x8 qf[4];
#pragma unroll
    for (int d0 = 0; d0 < 4; ++d0) qf[d0] = (bf16x8){0, 0, 0, 0, 0, 0, 0, 0};
    if (active) { const bf16_t* qrow = U.Q + (size_t)(32 * w + r) * U.qp + 8 * h;
#pragma unroll
        for (int d0 = 0; d0 < 4; ++d0) qf[d0] = *(const bf16x8*)(qrow + 16 * d0); }
    float m = -1e30f, l = 0.f; f32x16 o0, o1;
#pragma unroll
    for (int i = 0; i < 16; ++i) { o0[i] = 0.f; o1[i] = 0.f; }
    const int qpos = U.qpos0 + 32 * w + r;
    const int tlast = U.causal ? ((U.qpos0 + 32 * w + 31) >> 6) : (U.ntiles - 1);
    const bool hasb = (U.bias != nullptr) && (tid < 64);
    u32x4 kreg = *(const u32x4*)kg, vreg = *(const u32x4*)vg; float breg = hasb ? U.bias[tid] : 0.f;
    *(LAS u32x4*)(Kb + soff) = kreg; *(LAS u32x4*)(Vb + soff) = vreg; if (tid < 64) Bb[tid] = breg;
    __syncthreads();
    const int q4 = (lane & 15) >> 2, p4 = lane & 3, blk = (lane >> 4) & 1;
    const unsigned voff = (4 * h + q4) * KROW + 32 * blk + 8 * p4;
    const unsigned koff = r * KROW + 16 * h;
    for (int t = 0; t < U.ntiles; ++t) {
        const int cur = t & 1; const bool more = (t + 1 < U.ntiles);
        if (more) { kreg = *(const u32x4*)(kg + (size_t)(t + 1) * tstride); vreg = *(const u32x4*)(vg + (size_t)(t + 1) * tstride); if (hasb) breg = U.bias[(t + 1) * 64 + tid]; }
        if (active && t <= tlast) {
            const LAS unsigned char* Kt = Kb + cur * TILEB + koff; const LAS unsigned char* Vt = Vb + cur * TILEB + voff; const LAS float* Bt = Bb + cur * 64;
            f32x16 sa, sb;
#pragma unroll
            for (int g = 0; g < 4; ++g) { const f32x4 b0 = *(const LAS f32x4*)(Bt + 8 * g + 4 * h), b1 = *(const LAS f32x4*)(Bt + 32 + 8 * g + 4 * h);
#pragma unroll
                for (int j = 0; j < 4; ++j) { sa[4 * g + j] = b0[j]; sb[4 * g + j] = b1[j]; } }
#pragma unroll
            for (int d0 = 0; d0 < 4; ++d0) { const bf16x8 ka = *(const LAS bf16x8*)(Kt + 32 * d0), kb = *(const LAS bf16x8*)(Kt + 32 * KROW + 32 * d0);
                sa = MFMA32(ka, qf[d0], sa); sb = MFMA32(kb, qf[d0], sb); }
            if (U.causal && 64 * t + 63 > U.qpos0 + 32 * w) {
#pragma unroll
                for (int i = 0; i < 16; ++i) { const int key = 64 * t + crow(i, h); if (key > qpos) sa[i] = -1e30f; if (key + 32 > qpos) sb[i] = -1e30f; }
            }
            float mx = fmaxf(sa[0], sb[0]);
#pragma unroll
            for (int i = 1; i < 16; ++i) mx = fmaxf(mx, fmaxf(sa[i], sb[i]));
            mx = swapmax(mx);
            const float mnew = fmaxf(m, mx), alpha = __builtin_amdgcn_exp2f(m - mnew); m = mnew;
            float ls = 0.f;
#pragma unroll
            for (int i = 0; i < 16; ++i) { sa[i] = __builtin_amdgcn_exp2f(sa[i] - mnew); sb[i] = __builtin_amdgcn_exp2f(sb[i] - mnew); ls += sa[i] + sb[i]; }
            l = l * alpha + ls;
            if (__builtin_amdgcn_ballot_w64(alpha < 1.f) != 0ull) {
#pragma unroll
                for (int i = 0; i < 16; ++i) { o0[i] *= alpha; o1[i] *= alpha; }
            }
            bf16x8 pf[4];
#pragma unroll
            for (int s = 0; s < 2; ++s) {
                u32x4 pa, pb;
                pa.x = pk2(sa[8 * s], sa[8 * s + 1]); pa.y = pk2(sa[8 * s + 2], sa[8 * s + 3]); pa.z = pk2(sa[8 * s + 4], sa[8 * s + 5]); pa.w = pk2(sa[8 * s + 6], sa[8 * s + 7]);
                pb.x = pk2(sb[8 * s], sb[8 * s + 1]); pb.y = pk2(sb[8 * s + 2], sb[8 * s + 3]); pb.z = pk2(sb[8 * s + 4], sb[8 * s + 5]); pb.w = pk2(sb[8 * s + 6], sb[8 * s + 7]);
                pf[s] = __builtin_bit_cast(bf16x8, pa); pf[2 + s] = __builtin_bit_cast(bf16x8, pb);
            }
#pragma unroll
            for (int ks = 0; ks < 4; ++ks) {
#pragma unroll
                for (int db = 0; db < 2; ++db) {
                    const s16x4 lo = vtr(Vt + (16 * ks) * KROW + 64 * db), hi = vtr(Vt + (16 * ks + 8) * KROW + 64 * db);
                    const bf16x8 vf = __builtin_shufflevector(lo, hi, 0, 1, 2, 3, 4, 5, 6, 7);
                    if (db == 0) o0 = MFMA32(vf, pf[ks], o0); else o1 = MFMA32(vf, pf[ks], o1);
                }
            }
        }
        if (more) { const int nb = cur ^ 1; *(LAS u32x4*)(Kb + nb * TILEB + soff) = kreg; *(LAS u32x4*)(Vb + nb * TILEB + soff) = vreg; if (tid < 64) Bb[nb * 64 + tid] = breg; }
        __syncthreads();
    }
    if (active) {
        l = swapsum(l);
        const float inv = 1.0f / l;
        const size_t row = (size_t)(32 * w + r);
        const bf16_t* grow = U.G + row * U.gp; bf16_t* orow = U.O + row * U.op;
#pragma unroll
        for (int db = 0; db < 2; ++db)
#pragma unroll
            for (int g = 0; g < 4; ++g) {
                const int d = 32 * db + 8 * g + 4 * h;
                const u32x2 gv = *(const u32x2*)(grow + d);
                float a0, a1, a2, a3;
                if (db == 0) { a0 = o0[4 * g]; a1 = o0[4 * g + 1]; a2 = o0[4 * g + 2]; a3 = o0[4 * g + 3]; } else { a0 = o1[4 * g]; a1 = o1[4 * g + 1]; a2 = o1[4 * g + 2]; a3 = o1[4 * g + 3]; }
                u32x2 ov; ov.x = pk2(silu_f(bf_lo(gv.x)) * a0 * inv, silu_f(bf_hi(gv.x)) * a1 * inv); ov.y = pk2(silu_f(bf_lo(gv.y)) * a2 * inv, silu_f(bf_hi(gv.y)) * a3 * inv);
                *(u32x2*)(orow + d) = ov;
            }
    }
}

__device__ __forceinline__ void pool_unit(const Params& P, int tt, LAS unsigned char* lds, int tid) {
    asm volatile("" : "+v"(tid));
    const bf16_t* H = (const bf16_t*)(P.ws + WS_H); bf16_t* CAT = (bf16_t*)(P.ws + WS_XN);
    const int R0 = 64 * tt; const bool prompt = R0 < MP; const int s0 = prompt ? (R0 & (SEQ - 1)) : 0;
    LAS float* Ut = (LAS float*)lds;
    LAS bf16_t* Pt = (LAS bf16_t*)(lds + 81920);
    for (int e = tid; e < 79 * 32; e += 512) {
        const int rr = e >> 5, c8 = (e & 31) * 8, sl = rr - 15;
        f32x4 a = {0.f, 0.f, 0.f, 0.f}, c = {0.f, 0.f, 0.f, 0.f};
        if (sl >= 0 || (prompt && s0 + sl >= 0)) {
            const u32x4 hv = *(const u32x4*)(H + (size_t)(R0 + sl) * NH + C_U + c8);
            a = (f32x4){bf_lo(hv.x), bf_hi(hv.x), bf_lo(hv.y), bf_hi(hv.y)}; c = (f32x4){bf_lo(hv.z), bf_hi(hv.z), bf_lo(hv.w), bf_hi(hv.w)};
        } else if (!prompt) {
            const float* sp = P.state_pool + ((size_t)((R0 - MP) >> 6) * 15 + rr) * 256 + c8; a = *(const f32x4*)sp; c = *(const f32x4*)(sp + 4);
        }
        *(LAS f32x4*)(Ut + rr * 256 + c8) = a; *(LAS f32x4*)(Ut + rr * 256 + c8 + 4) = c;
    }
    __syncthreads();
    {
        const int c = tid & 255, half = tid >> 8, g = c >> 6, wn = 2 << g;
        for (int s = half * 32; s < half * 32 + 32; ++s) {
            float sum = 0.f;
            for (int j = 0; j < wn; ++j) sum += Ut[(15 + s - j) * 256 + c];
            const int cnt = prompt ? min(wn, s0 + s + 1) : wn;
            const float pooled = sum / (float)cnt - Ut[(15 + s) * 256 + c];
            Pt[s * 264 + c] = (bf16_t)(pk2(pooled, 0.f) & 0xffffu);
        }
    }
    __syncthreads();
    {
        const int lane = tid & 63, wv = tid >> 6, r = lane & 31, h = lane >> 5, g = wv >> 1, th = wv & 1;
        f32x16 a0, a1;
#pragma unroll
        for (int i = 0; i < 16; ++i) { a0[i] = 0.f; a1[i] = 0.f; }
#pragma unroll
        for (int s = 0; s < 4; ++s) {
            const bf16x8 b = *(const LAS bf16x8*)(Pt + (32 * th + r) * 264 + g * 64 + 16 * s + 8 * h);
            const float* wp = P.w_pool + ((size_t)(g * 64) + 16 * s + 8 * h) * 64 + r;
            u32x4 w0, w1;
            w0.x = pk2(wp[0 * 64], wp[1 * 64]); w0.y = pk2(wp[2 * 64], wp[3 * 64]); w0.z = pk2(wp[4 * 64], wp[5 * 64]); w0.w = pk2(wp[6 * 64], wp[7 * 64]);
            w1.x = pk2(wp[0 * 64 + 32], wp[1 * 64 + 32]); w1.y = pk2(wp[2 * 64 + 32], wp[3 * 64 + 32]); w1.z = pk2(wp[4 * 64 + 32], wp[5 * 64 + 32]); w1.w = pk2(wp[6 * 64 + 32], wp[7 * 64 + 32]);
            a0 = MFMA32(__builtin_bit_cast(bf16x8, w0), b, a0); a1 = MFMA32(__builtin_bit_cast(bf16x8, w1), b, a1);
        }
        const size_t row = (size_t)(R0 + 32 * th + r);
#pragma unroll
        for (int db = 0; db < 2; ++db)
#pragma unroll
            for (int g4 = 0; g4 < 4; ++g4) {
                const int col = g * 64 + 32 * db + 8 * g4 + 4 * h;
                const f32x4 ps = *(const f32x4*)(P.pool_scale + col);
                const u32x2 gv = *(const u32x2*)(H + row * NH + C_GP + col);
                float v0, v1, v2, v3;
                if (db == 0) { v0 = a0[4 * g4]; v1 = a0[4 * g4 + 1]; v2 = a0[4 * g4 + 2]; v3 = a0[4 * g4 + 3]; } else { v0 = a1[4 * g4]; v1 = a1[4 * g4 + 1]; v2 = a1[4 * g4 + 2]; v3 = a1[4 * g4 + 3]; }
                u32x2 ov; ov.x = pk2(silu_f(bf_lo(gv.x)) * v0 * ps.x, silu_f(bf_hi(gv.x)) * v1 * ps.y); ov.y = pk2(silu_f(bf_lo(gv.y)) * v2 * ps.z, silu_f(bf_hi(gv.y)) * v3 * ps.w);
                *(u32x2*)(CAT + row * DM + 512 + col) = ov;
            }
    }
    __syncthreads();
}

constexpr int NU_FOXP = 512, NU_FOXS = 64, NU_MEMP = 256, NU_MEMS = 32, NU_POOL = MTOT / 64;
constexpr int NU_TOTAL = NU_FOXP + NU_FOXS + NU_MEMP + NU_MEMS + NU_POOL;

__device__ __forceinline__ void p2_unit(const Params& P, int idx, LAS unsigned char* lds, int tid) {
    const bf16_t* H = (const bf16_t*)(P.ws + WS_H); bf16_t* CAT = (bf16_t*)(P.ws + WS_XN);
    AUnit U;
    if (idx < NU_FOXP) {
        const int qb = 15 - (idx >> 5), bh = idx & 31, b = bh >> 3, h = bh & 7; const size_t row0 = (size_t)b * SEQ + 256 * qb;
        U.Q = H + row0 * NH + C_Q + h * 64; U.K = H + (size_t)b * SEQ * NH + C_K + h * 64; U.V = H + (size_t)b * SEQ * NH + C_V + h * 64;
        U.bias = (const float*)(P.ws + WS_BIASP) + (size_t)bh * SEQ; U.G = H + row0 * NH + C_GF + h * 64; U.O = CAT + row0 * DM + h * 64;
        U.qp = NH; U.kvp = NH; U.gp = NH; U.op = DM; U.nq = 256; U.ntiles = 4 * qb + 4; U.qpos0 = 256 * qb; U.causal = 1;
    } else if (idx < NU_FOXP + NU_FOXS) {
        const int bh = idx - NU_FOXP, b = bh >> 3, h = bh & 7; const size_t row0 = (size_t)MP + b * DSEQ;
        U.Q = H + row0 * NH + C_Q + h * 64; U.K = (const bf16_t*)(P.ws + WS_KC) + (size_t)b * KTOT * 512 + h * 64; U.V = (const bf16_t*)(P.ws + WS_VC) + (size_t)b * KTOT * 512 + h * 64;
        U.bias = (const float*)(P.ws + WS_BIASS) + (size_t)bh * KTOT; U.G = H + row0 * NH + C_GF + h * 64; U.O = CAT + row0 * DM + h * 64;
        U.qp = NH; U.kvp = 512; U.gp = NH; U.op = DM; U.nq = 64; U.ntiles = KTOT / 64; U.qpos0 = PAST; U.causal = 1;
    } else if (idx < NU_FOXP + NU_FOXS + NU_MEMP) {
        const int i = idx - NU_FOXP - NU_FOXS, qb = i >> 4, b = (i >> 2) & 3, mh = i & 3; const size_t row0 = (size_t)b * SEQ + 256 * qb;
        const bf16_t* MKV = (const bf16_t*)(P.ws + WS_MKV);
        U.Q = H + row0 * NH + C_QM + mh * 64; U.K = MKV + (size_t)b * MEMT * 512 + mh * 64; U.V = U.K + 256;
        U.bias = nullptr; U.G = H + row0 * NH + C_GM + mh * 64; U.O = CAT + row0 * DM + 768 + mh * 64;
        U.qp = NH; U.kvp = 512; U.gp = NH; U.op = DM; U.nq = 256; U.ntiles = 4; U.qpos0 = 0; U.causal = 0;
    } else if (idx < NU_FOXP + NU_FOXS + NU_MEMP + NU_MEMS) {
        const int i = idx - NU_FOXP - NU_FOXS - NU_MEMP, b = i >> 2, mh = i & 3; const size_t row0 = (size_t)MP + b * DSEQ;
        U.Q = H + row0 * NH + C_QM + mh * 64; U.K = (const bf16_t*)(P.ws + WS_CMK) + (size_t)b * MEMT * 256 + mh * 64; U.V = (const bf16_t*)(P.ws + WS_CMV) + (size_t)b * MEMT * 256 + mh * 64;
        U.bias = nullptr; U.G = H + row0 * NH + C_GM + mh * 64; U.O = CAT + row0 * DM + 768 + mh * 64;
        U.qp = NH; U.kvp = 256; U.gp = NH; U.op = DM; U.nq = 64; U.ntiles = 4; U.qpos0 = 0; U.causal = 0;
    } else { pool_unit(P, idx - (NU_FOXP + NU_FOXS + NU_MEMP + NU_MEMS), lds, tid); return; }
    attn_unit(U, lds, tid);
}

__global__ void __launch_bounds__(512, 2) hymba_fwd(Params P) {
    extern __shared__ __attribute__((aligned(16))) unsigned char lds_raw[];
    LAS unsigned char* lds = (LAS unsigned char*)lds_raw;
    cg::grid_group grid = cg::this_grid();
    const int tid = threadIdx.x, G = gridDim.x;
    unsigned char* ws = P.ws;
    if (P.out == nullptr) grid.sync();
    volatile LAS unsigned* MISC = (volatile LAS unsigned*)(lds + LDS_MISC);
    if (tid < 2) MISC[tid] = 0u;
    __syncthreads();
    XcdBarrier bar = xcd_barrier_post((unsigned*)(ws + WS_CTL) + CW_BAR, MISC);
#define GRID_SYNC() xcd_barrier(bar)

    p0_prologue(P, lds, tid, G);
    GRID_SYNC();

    for (int sid = G - 1 - (int)blockIdx.x; sid < 96; sid += G) scan_seq(P, sid, lds, tid);
    {
        pg8::Gemm g{(const bf16_t*)(ws + WS_XN), (const bf16_t*)(ws + WS_WIN), MTOT, NH, DM}; pg8::StaticOrder S; S.init(MTOT, NH, G, (int)blockIdx.x);
        pg8::EpiIn E{(bf16_t*)(ws + WS_H), P.out, (bf16_t*)(ws + WS_KC), (bf16_t*)(ws + WS_VC)};
        pg8::gemm_phase<pg8::EpiIn, pg8::StaticOrder, true, true>(lds, g, S, E);
    }
    {
        pg8::Gemm g{(const bf16_t*)(ws + WS_MEMN), (const bf16_t*)(ws + WS_WMEM), MMEM, 512, DM}; pg8::StaticOrder S; S.init(MMEM, 512, G, (int)((blockIdx.x + G - (24 % G)) % G));
        pg8::EpiMem E{(bf16_t*)(ws + WS_MKV), P.out};
        pg8::gemm_phase<pg8::EpiMem, pg8::StaticOrder, true, true>(lds, g, S, E);
    }
    GRID_SYNC();

    {
        unsigned* qhead = (unsigned*)(ws + WS_CTL);
        volatile LAS int* slot = (volatile LAS int*)(lds + LDS_Q);
        for (;;) {
            if (tid == 0) *slot = (int)atomicAdd(qhead, 1u);
            __syncthreads();
            const int idx = *slot;
            __syncthreads();
            if (idx >= NU_TOTAL) break;
            p2_unit(P, idx, lds, tid);
        }
    }
    GRID_SYNC();

    {
        pg8::Gemm g{(const bf16_t*)(ws + WS_XN), (const bf16_t*)(ws + WS_WOUT), MTOT, DM, DM}; pg8::StaticOrder S; S.init(MTOT, DM, G, (int)blockIdx.x);
        pg8::EpiOut E{P.x_prompt, P.x_sample, P.out + O_Y};
        pg8::gemm_phase<pg8::EpiOut, pg8::StaticOrder, true, true>(lds, g, S, E);
    }
    GRID_SYNC();

    {
        int tid4 = tid; asm volatile("" : "+v"(tid4));
        const int lane = tid4 & 63, gw = blockIdx.x * 8 + (tid4 >> 6), NGW = G * 8;
        const f32x4* gr = (const f32x4*)P.g_final + lane;
        for (int m = gw; m < MTOT; m += NGW) {
            f32x4* yr = (f32x4*)(P.out + O_Y + (size_t)m * DM) + lane;
            f32x4 v[4]; float s = 0.f;
#pragma unroll
            for (int j = 0; j < 4; ++j) { v[j] = yr[64 * j]; s += (v[j].x * v[j].x + v[j].y * v[j].y) + (v[j].z * v[j].z + v[j].w * v[j].w); }
            const float rs = 1.0f / sqrtf(wave_sum(s) * (1.f / DM) + EPS);
#pragma unroll
            for (int j = 0; j < 4; ++j) yr[64 * j] = v[j] * rs * gr[64 * j];
        }
    }
}

extern "C" void kernel_launch(void* const* d_in, const int* in_sizes, int n_in, void* d_out, int out_size, void* d_ws, size_t ws_size, hipStream_t stream) {
    static int grid = 0;
    if (grid == 0) {
        int dev = 0, cus = 0, per_cu = 0;
        hipGetDevice(&dev);
        hipDeviceGetAttribute(&cus, hipDeviceAttributeMultiprocessorCount, dev);
        hipFuncSetAttribute((const void*)hymba_fwd, hipFuncAttributeMaxDynamicSharedMemorySize, LDS_BYTES);
        hipOccupancyMaxActiveBlocksPerMultiprocessor(&per_cu, (const void*)hymba_fwd, 512, LDS_BYTES);
        if (per_cu < 1) { fprintf(stderr, "kernel_launch: occupancy query says %d blocks/CU\n", per_cu); per_cu = 1; }
        (void)hipGetLastError();
        grid = cus;
        if (ws_size < WS_END) { fprintf(stderr, "kernel_launch: workspace too small\n"); grid = -1; }
    }
    if (grid < 0) return;
    if (hipMemsetAsync((char*)d_ws + WS_CTL, 0, CTL_ZERO_BYTES, stream) != hipSuccess) { fprintf(stderr, "kernel_launch: memset failed\n"); return; }
    Params p{};
    p.x_prompt = (const float*)d_in[0]; p.x_sample = (const float*)d_in[1]; p.mem_prompt = (const float*)d_in[2]; p.cache_k = (const float*)d_in[3];
    p.cache_v = (const float*)d_in[4]; p.cache_logf = (const float*)d_in[5]; p.cache_mk = (const float*)d_in[6]; p.cache_mv = (const float*)d_in[7];
    p.state_pool = (const float*)d_in[8]; p.g_norm = (const float*)d_in[9]; p.w_in = (const float*)d_in[10]; p.b_f = (const float*)d_in[11];
    p.w_pool = (const float*)d_in[12]; p.pool_scale = (const float*)d_in[13]; p.g_mem = (const float*)d_in[14]; p.w_mem_kv = (const float*)d_in[15];
    p.w_out = (const float*)d_in[16]; p.g_final = (const float*)d_in[17];
    p.out = (float*)d_out; p.ws = (unsigned char*)d_ws;
    void* args[] = {&p};
    hipError_t e = hipLaunchCooperativeKernel((const void*)hymba_fwd, dim3(grid), dim3(512), args, LDS_BYTES, stream);
    if (e != hipSuccess) fprintf(stderr, "cooperative launch failed: %s (grid %d)\n", hipGetErrorString(e), grid);
}
```

```cpp
#include <hip/hip_runtime.h>
#include <hip/hip_cooperative_groups.h>
#include <cstdio>
#include <cstdint>
namespace cg = cooperative_groups;
#define LAS __attribute__((address_space(3)))
namespace pg8 {
#define PG8_LAS __attribute__((address_space(3)))
typedef unsigned short bf16_t;
typedef short bf16x8 __attribute__((ext_vector_type(8)));
typedef float f32x4 __attribute__((ext_vector_type(4)));
typedef unsigned u32x4 __attribute__((ext_vector_type(4)));
constexpr int BM = 256, BK = 64, HALF = 128, HTB = HALF * BK * 2  , STAGE_BYTES = 8 * HTB, NXCD = 8, WGM = 8;

__host__ __device__ __forceinline__ int lds_byte(int r, int c) { const int st = (r >> 4) * 2 + (c >> 5), rr = r & 15, cc = c & 31, ob = rr * 64 + cc * 2; return st * 1024 + (ob ^ (((ob >> 9) & 1) << 5)); }
__host__ __device__ __forceinline__ void stage_rc(int b, int& R, int& C) { const int st = b / 1024, sb = b % 1024, swz = sb ^ (((sb >> 9) & 1) << 5); R = (st >> 1) * 16 + swz / 64; C = (st & 1) * 32 + (swz % 64) / 2; }
__host__ __device__ __forceinline__ int perm32(int rho) { const int n = rho >> 4, i = rho & 15; return 8 * (i >> 2) + 4 * n + (i & 3); }

struct Unit { int pm, pn; };
struct Gemm { const bf16_t* A; const bf16_t* Bt; int M, N, K; };

struct StaticOrder {
    int nM, nN, nwg, G, c;
    __host__ __device__ void init(int M, int N, int G_, int c_) { nM = M / BM; nN = N / BM; nwg = nM * nN; G = G_; c = c_; }
    __host__ __device__ bool next(int i, Unit& u) const {
        const long L = (long)i * G + c; if (L >= nwg) return false;
        int wgid = (int)L; { const int q = nwg / NXCD, r = nwg % NXCD, xcd = wgid % NXCD, off = wgid / NXCD; wgid = (xcd < r ? xcd * (q + 1) : r * (q + 1) + (xcd - r) * q) + off; }
        const int nig = WGM * nN, gid = wgid / nig, fm = gid * WGM, gsz = (nM - fm) < WGM ? (nM - fm) : WGM;
        u.pm = fm + ((wgid % nig) % gsz); u.pn = (wgid % nig) / gsz; return true;
    }
    __device__ __forceinline__ void a_ready(const Unit&) const {}
    __device__ __forceinline__ void done(const Unit&) const {}
};

__device__ __forceinline__ unsigned cvt_pk_bf16(float lo, float hi) { unsigned r; asm volatile("v_cvt_pk_bf16_f32 %0, %1, %2" : "=v"(r) : "v"(lo), "v"(hi)); return r; }
template <class Epi, class Sched, bool ALIGN_EPI = false, bool SP2 = false>
__device__ __forceinline__ void gemm_phase(PG8_LAS unsigned char* lds, const Gemm g, const Sched& S, const Epi& E) {
    int tid_l = threadIdx.x; asm volatile("" : "+v"(tid_l));
    const int tid = tid_l, wid = __builtin_amdgcn_readfirstlane(tid >> 6), lane = tid & 63, wr = wid >> 2, wc = wid & 3, fr = lane & 15, fq = lane >> 4;
    const int K = g.K, nt = K / BK;
    unsigned voffA[2], voffB[2];
#pragma unroll
    for (int i = 0; i < 2; ++i) { int R, C; stage_rc(tid * 16 + i * 8192, R, C); const int Rb = Epi::PERM ? ((R & ~31) + perm32(R & 31)) : R;
        voffA[i] = (unsigned)(R * K + C) * 2u; voffB[i] = (unsigned)(Rb * K + C) * 2u; }
    const size_t kstep = (size_t)(BK * 2);
    const size_t hstep = (size_t)HALF * K * 2;
    const size_t tstep = 2 * hstep;
    const unsigned ldsw = (unsigned)wid * 1024u;
    const int aoff = lds_byte(wr * 64 + fr, fq * 8), boff = lds_byte(wc * 32 + fr, fq * 8);
#define PG8_SA(b, h) (((b) * 2 + (h)) * HTB)
#define PG8_SB(b, h) ((4 + (b) * 2 + (h)) * HTB)
#define PG8_STAGE(bufoff, gbase, voff) do { _Pragma("unroll") for (int _i = 0; _i < 2; ++_i) \
        __builtin_amdgcn_global_load_lds((const unsigned*)((const char*)(gbase) + (voff)[_i]), (PG8_LAS unsigned*)(lds + (bufoff) + ldsw + _i * 8192), 16, 0, 0); } while (0)
#define PG8_LDA(dst, b, h) do { _Pragma("unroll") for (int m = 0; m < 4; ++m) _Pragma("unroll") for (int k = 0; k < 2; ++k) dst[m][k] = *(const PG8_LAS bf16x8*)(lds + PG8_SA(b, h) + aoff + m * 2048 + k * 1024); } while (0)
#define PG8_LDB(dst, b, h) do { _Pragma("unroll") for (int n = 0; n < 2; ++n) _Pragma("unroll") for (int k = 0; k < 2; ++k) dst[n][k] = *(const PG8_LAS bf16x8*)(lds + PG8_SB(b, h) + boff + n * 2048 + k * 1024); } while (0)
#define PG8_MMA(ai, bj, At, Bt) do { __builtin_amdgcn_s_setprio(1); _Pragma("unroll") for (int m = 0; m < 4; ++m) _Pragma("unroll") for (int n = 0; n < 2; ++n) _Pragma("unroll") for (int k = 0; k < 2; ++k) \
        acc[ai][bj][m][n] = __builtin_amdgcn_mfma_f32_16x16x32_bf16(Bt[n][k], At[m][k], acc[ai][bj][m][n], 0, 0, 0); __builtin_amdgcn_s_setprio(0); } while (0)
#define PG8_WAIT_V(n) asm volatile("s_waitcnt vmcnt(" #n ")" ::: "memory")
#define PG8_WAIT_L(n) asm volatile("s_waitcnt lgkmcnt(" #n ")" ::: "memory")
#define PG8_BAR __builtin_amdgcn_s_barrier()
#define PG8_SCHED __builtin_amdgcn_sched_barrier(0)
    Unit cur, nxt; int ui = 0;
    if (!S.next(0, cur)) return;
    f32x4 acc[2][2][4][2];
#pragma unroll
    for (int a = 0; a < 2; ++a)
#pragma unroll
        for (int b = 0; b < 2; ++b)
#pragma unroll
            for (int m = 0; m < 4; ++m)
#pragma unroll
                for (int n = 0; n < 2; ++n) acc[a][b][m][n] = (f32x4){0.f, 0.f, 0.f, 0.f};
    bf16x8 At[4][2], B0[2][2], B1[2][2];
    const char* cA = (const char*)g.A + (size_t)cur.pm * tstep; const char* cB = (const char*)g.Bt + (size_t)cur.pn * tstep;
    S.a_ready(cur);
    if constexpr (SP2) {
        PG8_STAGE(PG8_SB(0, 0), cB, voffB); PG8_STAGE(PG8_SB(0, 1), cB + hstep, voffB); PG8_STAGE(PG8_SA(0, 0), cA, voffA); PG8_STAGE(PG8_SA(0, 1), cA + hstep, voffA);
        if (wr == 1) PG8_BAR;
        PG8_WAIT_V(2); PG8_BAR;
        PG8_STAGE(PG8_SB(1, 0), cB + kstep, voffB); PG8_STAGE(PG8_SA(1, 0), cA + kstep, voffA); PG8_STAGE(PG8_SB(1, 1), cB + hstep + kstep, voffB);
        PG8_WAIT_V(6); PG8_BAR;
    } else {
        PG8_STAGE(PG8_SB(0, 0), cB, voffB); PG8_STAGE(PG8_SA(0, 0), cA, voffA); PG8_STAGE(PG8_SB(0, 1), cB + hstep, voffB); PG8_STAGE(PG8_SA(0, 1), cA + hstep, voffA);
        if (wr == 1) PG8_BAR;
        PG8_WAIT_V(4); PG8_BAR;
        PG8_STAGE(PG8_SB(1, 0), cB + kstep, voffB); PG8_STAGE(PG8_SA(1, 0), cA + kstep, voffA); PG8_STAGE(PG8_SB(1, 1), cB + hstep + kstep, voffB);
        PG8_WAIT_V(6); PG8_BAR;
    }
    for (;;) {
        const bool has_next = S.next(ui + 1, nxt);
        const char* nA = has_next ? (const char*)g.A + (size_t)nxt.pm * tstep : cA; const char* nB = has_next ? (const char*)g.Bt + (size_t)nxt.pn * tstep : cB;
        for (int t = 0; t < nt; t += 2) {
            const bool last = (t == nt - 2);
            const char* a1 = cA + (size_t)(t + 1) * kstep;
            const char* a2 = last ? nA : cA + (size_t)(t + 2) * kstep; const char* b2 = last ? nB : cB + (size_t)(t + 2) * kstep;
            const char* a3 = a2 + kstep; const char* b3 = b2 + kstep;
            if (last && has_next) S.a_ready(nxt);
            if constexpr (SP2) {
            PG8_LDB(B0, 0, 0); PG8_LDB(B1, 0, 1); PG8_SCHED; PG8_LDA(At, 0, 0); PG8_STAGE(PG8_SA(1, 1), a1 + hstep, voffA);
            PG8_WAIT_V(8); PG8_WAIT_L(0); PG8_BAR; PG8_MMA(0, 0, At, B0); PG8_MMA(0, 1, At, B1); PG8_BAR; PG8_SCHED;
            PG8_LDA(At, 0, 1); PG8_STAGE(PG8_SB(0, 0), b2, voffB); PG8_STAGE(PG8_SB(0, 1), b2 + hstep, voffB); PG8_STAGE(PG8_SA(0, 0), a2, voffA);
            PG8_WAIT_V(8); PG8_WAIT_L(0); PG8_BAR; PG8_MMA(1, 0, At, B0); PG8_MMA(1, 1, At, B1); PG8_BAR; PG8_SCHED;
            PG8_LDB(B0, 1, 0); PG8_LDB(B1, 1, 1); PG8_SCHED; PG8_LDA(At, 1, 0); PG8_STAGE(PG8_SA(0, 1), a2 + hstep, voffA);
            PG8_WAIT_V(8); PG8_WAIT_L(0); PG8_BAR; PG8_MMA(0, 0, At, B0); PG8_MMA(0, 1, At, B1); PG8_BAR; PG8_SCHED;
            PG8_LDA(At, 1, 1); PG8_STAGE(PG8_SB(1, 0), b3, voffB); PG8_STAGE(PG8_SB(1, 1), b3 + hstep, voffB); PG8_STAGE(PG8_SA(1, 0), a3, voffA);
            PG8_WAIT_V(8); PG8_WAIT_L(0); PG8_BAR; PG8_MMA(1, 0, At, B0); PG8_MMA(1, 1, At, B1); PG8_BAR; PG8_SCHED;
            } else {
            PG8_LDB(B0, 0, 0); PG8_SCHED; PG8_LDA(At, 0, 0); PG8_STAGE(PG8_SA(1, 1), a1 + hstep, voffA);
            PG8_WAIT_L(8); PG8_BAR; PG8_WAIT_L(0); PG8_MMA(0, 0, At, B0); PG8_BAR; PG8_SCHED;
            PG8_LDB(B1, 0, 1); PG8_STAGE(PG8_SB(0, 0), b2, voffB);
            PG8_BAR; PG8_WAIT_L(0); PG8_MMA(0, 1, At, B1); PG8_BAR;
            PG8_LDA(At, 0, 1); PG8_STAGE(PG8_SA(0, 0), a2, voffA);
            PG8_BAR; PG8_WAIT_L(0); PG8_MMA(1, 0, At, B0); PG8_BAR; PG8_SCHED;
            PG8_STAGE(PG8_SB(0, 1), b2 + hstep, voffB);
            PG8_WAIT_V(6); PG8_BAR; PG8_MMA(1, 1, At, B1); PG8_BAR;
            PG8_LDB(B0, 1, 0); PG8_SCHED; PG8_LDA(At, 1, 0); PG8_STAGE(PG8_SA(0, 1), a2 + hstep, voffA);
            PG8_WAIT_L(8); PG8_BAR; PG8_WAIT_L(0); PG8_MMA(0, 0, At, B0); PG8_BAR; PG8_SCHED;
            PG8_LDB(B1, 1, 1); PG8_STAGE(PG8_SB(1, 0), b3, voffB);
            PG8_BAR; PG8_WAIT_L(0); PG8_MMA(0, 1, At, B1); PG8_BAR;
            PG8_LDA(At, 1, 1); PG8_STAGE(PG8_SA(1, 0), a3, voffA);
            PG8_BAR; PG8_WAIT_L(0); PG8_MMA(1, 0, At, B0); PG8_BAR; PG8_SCHED;
            PG8_STAGE(PG8_SB(1, 1), b3 + hstep, voffB);
            PG8_WAIT_V(6); PG8_BAR; PG8_MMA(1, 1, At, B1); PG8_BAR;
            }
        }
        if constexpr (ALIGN_EPI) { if (wr == 0) PG8_BAR; }
        if constexpr (!Epi::AFTER_DRAIN) { E(acc, cur, wr, wc, fr, fq); S.done(cur); }
        if (!has_next) break;
#pragma unroll
        for (int a = 0; a < 2; ++a)
#pragma unroll
            for (int b = 0; b < 2; ++b)
#pragma unroll
                for (int m = 0; m < 4; ++m)
#pragma unroll
                    for (int n = 0; n < 2; ++n) acc[a][b][m][n] = (f32x4){0.f, 0.f, 0.f, 0.f};
        cur = nxt; cA = nA; cB = nB; ++ui;
        if constexpr (ALIGN_EPI) { if (wr == 1) PG8_BAR; }
    }
    PG8_WAIT_V(0);
    if constexpr (!ALIGN_EPI) { if (wr == 0) PG8_BAR; }
    PG8_BAR;
    if constexpr (Epi::AFTER_DRAIN) { E.fused(acc, cur, wr, wc, fr, fq, lds, wid, lane); S.done(cur); }
#undef PG8_SA
#undef PG8_SB
#undef PG8_STAGE
#undef PG8_LDA
#undef PG8_LDB
#undef PG8_MMA
#undef PG8_WAIT_V
#undef PG8_WAIT_L
#undef PG8_BAR
#undef PG8_SCHED
}
}
#define XB_TMO      128
#define XB_XCNT(j)  (256  + 64 * (j))
#define XB_XSUB(j)  (1280 + 64 * (j))
#define XB_XGEN(j)  (2304 + 64 * (j))
#define XB_TOP      3328
#define XB_TOPGEN   3392
#define XCD_BAR_WORDS 3456
#define XB_SPIN_CAP (1u << 18)

__device__ __forceinline__ unsigned xb_ld(unsigned* p)              { return __hip_atomic_load(p, __ATOMIC_RELAXED, __HIP_MEMORY_SCOPE_AGENT); }
__device__ __forceinline__ unsigned xb_add(unsigned* p, unsigned v) { return __hip_atomic_fetch_add(p, v, __ATOMIC_RELAXED, __HIP_MEMORY_SCOPE_AGENT); }
__device__ __forceinline__ unsigned xb_xcc_id() { return (unsigned)__builtin_amdgcn_s_getreg((3 << 11) | 20) & 0xFu; }
#define XB_SPIN(cond, bar) do { unsigned _sp = 0; while (cond) { __builtin_amdgcn_s_sleep(1); \
    if ((++_sp & 255u) == 0u) { if (xb_ld(&(bar)[XB_TMO])) break; if (_sp > XB_SPIN_CAP) { atomicAdd(&(bar)[XB_TMO], 1u); break; } } } } while (0)

struct XcdBarrier {
    unsigned* bar; unsigned x;
    volatile LAS unsigned* st;
};

__device__ __forceinline__ XcdBarrier xcd_barrier_post(unsigned* bar, volatile LAS unsigned* st) {
    XcdBarrier b; b.bar = bar; b.x = xb_xcc_id(); b.st = st;
    if (threadIdx.x == 0) (void)xb_add(&bar[XB_XCNT(b.x)], 1u);
    return b;
}
__device__ __forceinline__ void xcd_barrier_complete(unsigned* bar, unsigned x, unsigned& nloc, unsigned& nx) {
    const unsigned G = gridDim.x * gridDim.y * gridDim.z;
    unsigned sum, cnt, mine, sp = 0u;
    for (;;) {
        sum = 0u; cnt = 0u; mine = 0u;
#pragma unroll
        for (unsigned j = 0; j < 16; ++j) { const unsigned c = xb_ld(&bar[XB_XCNT(j)]); sum += c; cnt += (c > 0u) ? 1u : 0u; mine = (j == x) ? c : mine; }
        if (sum == G) break;
        __builtin_amdgcn_s_sleep(1);
        if ((++sp & 255u) == 0u) { if (xb_ld(&bar[XB_TMO])) break; if (sp > XB_SPIN_CAP) { atomicAdd(&bar[XB_TMO], 1u); break; } }
    }
    nloc = mine > 0u ? mine : 1u; nx = cnt > 0u ? cnt : 1u;
}

__device__ __forceinline__ void xcd_barrier(const XcdBarrier& b) {
    asm volatile("s_waitcnt vmcnt(0)" ::: "memory");
    __syncthreads();
    if (threadIdx.x == 0) {
        unsigned* bar = b.bar;
        __builtin_amdgcn_s_waitcnt(0);
        unsigned nloc = b.st[0], nx = b.st[1];
        if (nloc == 0u) { xcd_barrier_complete(bar, b.x, nloc, nx); b.st[0] = nloc; b.st[1] = nx; }
        const unsigned old = xb_add(&bar[XB_XSUB(b.x)], 1u);
        const unsigned gen = old / nloc;
        if (old + 1u == (gen + 1u) * nloc) {
            __builtin_amdgcn_fence(__ATOMIC_RELEASE, "agent");
            asm volatile("s_waitcnt vmcnt(0)" ::: "memory");
            const unsigned og = xb_add(&bar[XB_TOP], 1u);
            const unsigned tg = og / nx;
            if (og + 1u == (tg + 1u) * nx) xb_add(&bar[XB_TOPGEN], 1u);
            else XB_SPIN(xb_ld(&bar[XB_TOPGEN]) == tg, bar);
            __builtin_amdgcn_fence(__ATOMIC_ACQUIRE, "agent");
            xb_add(&bar[XB_XGEN(b.x)], 1u);
            asm volatile("s_waitcnt vmcnt(0)" ::: "memory");
        } else {
            XB_SPIN(xb_ld(&bar[XB_XGEN(b.x)]) == gen, bar);
            __builtin_amdgcn_fence(__ATOMIC_ACQUIRE, "agent");
            asm volatile("s_waitcnt vmcnt(0)" ::: "memory");
        }
    }
    __syncthreads();
}

#define LAS __attribute__((address_space(3)))
typedef unsigned short bf16_t;
typedef float f32x4 __attribute__((ext_vector_type(4)));
typedef float f32x16 __attribute__((ext_vector_type(16)));
typedef short bf16x8 __attribute__((ext_vector_type(8)));
typedef short s16x4 __attribute__((ext_vector_type(4)));
typedef unsigned u32x4 __attribute__((ext_vector_type(4)));
typedef unsigned u32x2 __attribute__((ext_vector_type(2)));
typedef float f32x2_t __attribute__((ext_vector_type(2)));
typedef __bf16 bf16x2_t __attribute__((ext_vector_type(2)));

constexpr int DM = 1024, NB = 4, SEQ = 4096, DB = 8, DSEQ = 64, PAST = 2048, KTOT = PAST + DSEQ;
constexpr int FH = 8, HD = 64, MHEADS = 4, MEMT = 256, DIN = 3080;
constexpr int MP = NB * SEQ, MS = DB * DSEQ, MTOT = MP + MS, MMEM = NB * MEMT;
constexpr int NH = 3072;
constexpr int C_Q = 0, C_K = 512, C_V = 1024, C_GF = 1536, C_U = 2048, C_GP = 2304, C_QM = 2560, C_GM = 2816;
constexpr float EPS = 1e-6f, LOG2E = 1.4426950408889634f, C2 = 0.125f * LOG2E;
constexpr size_t O_Y = 0, O_K_P = 17301504, O_V_P = 25690112, O_LF_P = 34078720, O_MK_P = 34209792, O_MV_P = 34471936,
                 O_POOL_P = 34734080, O_K_S = 34749440, O_V_S = 35011584, O_LF_S = 35273728, O_POOL_S = 35277824;
constexpr size_t MiB = 1u << 20;
constexpr size_t WS_CTL = 0, WS_WIN = 1 * MiB, WS_WMEM = 7 * MiB, WS_WOUT = 8 * MiB, WS_MEMN = 10 * MiB, WS_MKV = 12 * MiB, WS_CMK = 13 * MiB,
                 WS_CMV = 14 * MiB, WS_BIASP = 15 * MiB, WS_BIASS = 16 * MiB, WS_KC = 17 * MiB, WS_VC = 34 * MiB, WS_XN = 51 * MiB, WS_H = 84 * MiB,
                 WS_END = 183 * MiB;
constexpr int LDS_BYTES = 147456;
constexpr int LDS_Q = 140000;
constexpr int LDS_MISC = 140032;
constexpr int CW_BAR = 4096;
constexpr size_t CTL_ZERO_BYTES = 65536;

struct Params {
    const float *x_prompt, *x_sample, *mem_prompt, *cache_k, *cache_v, *cache_logf, *cache_mk, *cache_mv, *state_pool;
    const float *g_norm, *w_in, *b_f, *w_pool, *pool_scale, *g_mem, *w_mem_kv, *w_out, *g_final;
    float* out; unsigned char* ws;
};

__device__ __forceinline__ unsigned pk2(float lo, float hi) { f32x2_t v = {lo, hi}; bf16x2_t b = __builtin_convertvector(v, bf16x2_t); return __builtin_bit_cast(unsigned, b); }
__device__ __forceinline__ float bf_lo(unsigned u) { return __uint_as_float(u << 16); }
__device__ __forceinline__ float bf_hi(unsigned u) { return __uint_as_float(u & 0xffff0000u); }
__device__ __forceinline__ float wave_sum(float v) {
#pragma unroll
    for (int o = 1; o < 64; o <<= 1) v += __shfl_xor(v, o);
    return v;
}
__device__ __forceinline__ float silu_f(float x) { return x * __builtin_amdgcn_rcpf(1.f + __expf(-x)); }
__device__ __forceinline__ int crow(int r, int hi) { return (r & 3) + 8 * (r >> 2) + 4 * hi; }
#define MFMA32(a, b, c) __builtin_amdgcn_mfma_f32_32x32x16_bf16((a), (b), (c), 0, 0, 0)

namespace pg8 {
struct EpiIn {
    static constexpr bool PERM = true, AFTER_DRAIN = false;
    bf16_t* H; float* out; bf16_t* KC; bf16_t* VC;
    __device__ __forceinline__ void operator()(const f32x4 (&acc)[2][2][4][2], const Unit& u, int wr, int wc, int fr, int fq) const {
        const int pn = u.pn;
        const float sc = (pn < 2 || pn == 10) ? C2 : 1.f;
        const int row0 = u.pm * BM + wr * 64 + fr, colb = pn * BM + wc * 32 + 8 * fq;
#pragma unroll
        for (int ai = 0; ai < 2; ++ai)
#pragma unroll
            for (int m = 0; m < 4; ++m) {
                const int row = row0 + ai * HALF + m * 16;
#pragma unroll
                for (int bj = 0; bj < 2; ++bj) {
                    const int col = colb + bj * HALF;
                    const f32x4 v0 = acc[ai][bj][m][0], v1 = acc[ai][bj][m][1];
                    u32x4 w; w.x = pk2(v0[0] * sc, v0[1] * sc); w.y = pk2(v0[2] * sc, v0[3] * sc); w.z = pk2(v1[0] * sc, v1[1] * sc); w.w = pk2(v1[2] * sc, v1[3] * sc);
                    *(u32x4*)(H + (size_t)row * NH + col) = w;
                    if (pn >= 2 && pn < 6) {
                        const bool isv = pn >= 4; const int c = col - (isv ? C_V : C_K);
                        float* dst;
                        if (row < MP) dst = out + (isv ? O_V_P : O_K_P) + (size_t)row * 512 + c;
                        else { const int rs = row - MP; dst = out + (isv ? O_V_S : O_K_S) + (size_t)rs * 512 + c;
                               bf16_t* cd = (isv ? VC : KC) + ((size_t)(rs >> 6) * KTOT + PAST + (rs & 63)) * 512 + c; *(u32x4*)cd = w; }
                        *(f32x4*)dst = v0; *(f32x4*)(dst + 4) = v1;
                    } else if (pn == 8) {
                        const int c = col - C_U; float* dst = nullptr;
                        if (row < MP) { const int s = row & (SEQ - 1); if (s >= SEQ - 15) dst = out + O_POOL_P + ((size_t)(row >> 12) * 15 + (s - (SEQ - 15))) * 256 + c; }
                        else { const int rs = row - MP, s = rs & 63; if (s >= DSEQ - 15) dst = out + O_POOL_S + ((size_t)(rs >> 6) * 15 + (s - (DSEQ - 15))) * 256 + c; }
                        if (dst) { *(f32x4*)dst = v0; *(f32x4*)(dst + 4) = v1; }
                    }
                }
            }
    }
};
struct EpiMem {
    static constexpr bool PERM = true, AFTER_DRAIN = false;
    bf16_t* MKV; float* out;
    __device__ __forceinline__ void operator()(const f32x4 (&acc)[2][2][4][2], const Unit& u, int wr, int wc, int fr, int fq) const {
        const int row0 = u.pm * BM + wr * 64 + fr, colb = u.pn * BM + wc * 32 + 8 * fq;
        float* ob = out + (u.pn ? O_MV_P : O_MK_P);
#pragma unroll
        for (int ai = 0; ai < 2; ++ai)
#pragma unroll
            for (int m = 0; m < 4; ++m) {
                const int row = row0 + ai * HALF + m * 16;
#pragma unroll
                for (int bj = 0; bj < 2; ++bj) {
                    const int col = colb + bj * HALF;
                    const f32x4 v0 = acc[ai][bj][m][0], v1 = acc[ai][bj][m][1];
                    u32x4 w; w.x = pk2(v0[0], v0[1]); w.y = pk2(v0[2], v0[3]); w.z = pk2(v1[0], v1[1]); w.w = pk2(v1[2], v1[3]);
                    *(u32x4*)(MKV + (size_t)row * 512 + col) = w;
                    float* dst = ob + (size_t)row * 256 + (col - u.pn * BM);
                    *(f32x4*)dst = v0; *(f32x4*)(dst + 4) = v1;
                }
            }
    }
};
struct EpiOut {
    static constexpr bool PERM = false, AFTER_DRAIN = false;
    const float* xp; const float* xs; float* y;
    __device__ __forceinline__ void operator()(const f32x4 (&acc)[2][2][4][2], const Unit& u, int wr, int wc, int fr, int fq) const {
        const int row0 = u.pm * BM + wr * 64 + fr, colb = u.pn * BM + wc * 32 + 4 * fq;
        const float* xb = (u.pm * BM < MP) ? xp : (xs - (size_t)MP * DM);
#pragma unroll
        for (int ai = 0; ai < 2; ++ai)
#pragma unroll
            for (int m = 0; m < 4; ++m) {
                const size_t off = (size_t)(row0 + ai * HALF + m * 16) * DM + colb;
#pragma unroll
                for (int bj = 0; bj < 2; ++bj)
#pragma unroll
                    for (int n = 0; n < 2; ++n) {
                        const f32x4 xv = *(const f32x4*)(xb + off + bj * HALF + n * 16);
                        *(f32x4*)(y + off + bj * HALF + n * 16) = xv + acc[ai][bj][m][n];
                    }
            }
    }
};
}

__device__ __forceinline__ void transpose_item(const float* W, int pitch, int src_col0, bf16_t* WT, int K, int dst_row0, int k0, LAS float* scr, int lane) {
#pragma unroll 8
    for (int i = 0; i < 32; ++i) { const int kk = 2 * i + (lane >> 5); scr[kk * 33 + (lane & 31)] = W[(size_t)(k0 + kk) * pitch + src_col0 + (lane & 31)]; }
    asm volatile("s_waitcnt lgkmcnt(0)" ::: "memory");
    const int c = lane & 7;
#pragma unroll
    for (int j = 0; j < 4; ++j) { const int n = (lane >> 3) + 8 * j; const LAS float* s = scr + (8 * c) * 33 + n;
        u32x4 o; o.x = pk2(s[0 * 33], s[1 * 33]); o.y = pk2(s[2 * 33], s[3 * 33]); o.z = pk2(s[4 * 33], s[5 * 33]); o.w = pk2(s[6 * 33], s[7 * 33]);
        *(u32x4*)(WT + (size_t)(dst_row0 + n) * K + k0 + 8 * c) = o; }
    asm volatile("s_waitcnt lgkmcnt(0)" ::: "memory");
}

__device__ __forceinline__ float log_sigmoid_f(float t) { return fminf(t, 0.f) - log1pf(__expf(-fabsf(t))); }

template <bool ZF>
__device__ __forceinline__ void norm_row(const float* xrow, const float* g, bf16_t* orow, int lane, const LAS float* wz, const float* bfv, float* lf_out) {
    const f32x4* xr = (const f32x4*)xrow + lane; const f32x4* gr = (const f32x4*)g + lane;
    f32x4 v[4]; float s = 0.f;
#pragma unroll
    for (int j = 0; j < 4; ++j) { v[j] = xr[64 * j]; s += (v[j].x * v[j].x + v[j].y * v[j].y) + (v[j].z * v[j].z + v[j].w * v[j].w); }
    const float rs = 1.0f / sqrtf(wave_sum(s) * (1.f / DM) + EPS);
    unsigned long long* o8 = (unsigned long long*)orow + lane;
#pragma unroll
    for (int j = 0; j < 4; ++j) { const f32x4 gv = gr[64 * j]; v[j] = v[j] * rs * gv;
        o8[64 * j] = (unsigned long long)pk2(v[j].x, v[j].y) | ((unsigned long long)pk2(v[j].z, v[j].w) << 32); }
    if (ZF) {
        float z[8];
#pragma unroll
        for (int hh = 0; hh < 8; ++hh) { float a = 0.f;
#pragma unroll
            for (int j = 0; j < 4; ++j) { const f32x4 w = *(const LAS f32x4*)(wz + hh * DM + 4 * (lane + 64 * j)); a += (v[j].x * w.x + v[j].y * w.y) + (v[j].z * w.z + v[j].w * w.w); }
            z[hh] = wave_sum(a); }
        float zz = z[0];
#pragma unroll
        for (int hh = 1; hh < 8; ++hh) zz = (lane == hh) ? z[hh] : zz;
        if (lane < 8) lf_out[lane] = log_sigmoid_f(zz + bfv[lane]);
    }
}

__device__ __forceinline__ void p0_prologue(const Params& P, LAS unsigned char* lds, int tid, int G) {
    asm volatile("" : "+v"(tid));
    const int lane = tid & 63, wave = tid >> 6;
    unsigned char* ws = P.ws;
    bf16_t* WIN = (bf16_t*)(ws + WS_WIN); bf16_t* WMEM = (bf16_t*)(ws + WS_WMEM); bf16_t* WOUT = (bf16_t*)(ws + WS_WOUT);
    bf16_t* XN = (bf16_t*)(ws + WS_XN); bf16_t* MEMN = (bf16_t*)(ws + WS_MEMN);
    LAS float* wz = (LAS float*)(lds + 73728);
    for (int e = tid; e < 8 * DM; e += 512) { const int k = e >> 3, j = e & 7; wz[j * DM + k] = P.w_in[(size_t)k * DIN + 2048 + j]; }
    LAS float* scr = (LAS float*)(lds + wave * 8704);
    const int gw = blockIdx.x * 8 + wave, NGW = G * 8;
    constexpr int I_IN = 16 * 96, I_MEM = 16 * 16, I_OUT = 16 * 32;
    for (int it = gw; it < I_IN + I_MEM + I_OUT; it += NGW) {
        int r = it;
        if (r < I_IN) { const int kb = r / 96, nb = r % 96, n0 = 32 * nb; transpose_item(P.w_in, DIN, n0 < 2048 ? n0 : n0 + 8, WIN, DM, n0, 64 * kb, scr, lane); continue; }
        r -= I_IN;
        if (r < I_MEM) { const int kb = r / 16, nb = r % 16; transpose_item(P.w_mem_kv, 512, 32 * nb, WMEM, DM, 32 * nb, 64 * kb, scr, lane); continue; }
        r -= I_MEM;
        { const int kb = r / 32, nb = r % 32; transpose_item(P.w_out, DM, 32 * nb, WOUT, DM, 32 * nb, 64 * kb, scr, lane); }
    }
    __syncthreads();
    for (int m = gw; m < MTOT + MMEM; m += NGW) {
        if (m < MP) norm_row<true>(P.x_prompt + (size_t)m * DM, P.g_norm, XN + (size_t)m * DM, lane, wz, P.b_f, P.out + O_LF_P + (size_t)m * 8);
        else if (m < MTOT) norm_row<true>(P.x_sample + (size_t)(m - MP) * DM, P.g_norm, XN + (size_t)m * DM, lane, wz, P.b_f, P.out + O_LF_S + (size_t)(m - MP) * 8);
        else norm_row<false>(P.mem_prompt + (size_t)(m - MTOT) * DM, P.g_mem, MEMN + (size_t)(m - MTOT) * DM, lane, wz, nullptr, nullptr);
    }
    const int gt = blockIdx.x * 512 + tid, NGT = G * 512;
    bf16_t* KC = (bf16_t*)(ws + WS_KC); bf16_t* VC = (bf16_t*)(ws + WS_VC); bf16_t* CMK = (bf16_t*)(ws + WS_CMK); bf16_t* CMV = (bf16_t*)(ws + WS_CMV);
    constexpr int PER_B = PAST * 512, NCK = DB * PER_B / 8;
    for (int i = gt; i < 2 * NCK; i += NGT) {
        const bool isv = i >= NCK; const int i8 = (isv ? i - NCK : i) * 8; const int b = i8 / PER_B, within = i8 - b * PER_B;
        const float* src = (isv ? P.cache_v : P.cache_k) + i8;
        const f32x4 a = *(const f32x4*)src, c = *(const f32x4*)(src + 4);
        u32x4 w; w.x = pk2(a.x, a.y); w.y = pk2(a.z, a.w); w.z = pk2(c.x, c.y); w.w = pk2(c.z, c.w);
        *(u32x4*)((isv ? VC : KC) + (size_t)b * KTOT * 512 + within) = w;
    }
    constexpr int NCM = DB * MEMT * 256 / 8;
    for (int i = gt; i < 2 * NCM; i += NGT) {
        const bool isv = i >= NCM; const int i8 = (isv ? i - NCM : i) * 8;
        const float* src = (isv ? P.cache_mv : P.cache_mk) + i8;
        const f32x4 a = *(const f32x4*)src, c = *(const f32x4*)(src + 4);
        u32x4 w; w.x = pk2(a.x, a.y); w.y = pk2(a.z, a.w); w.z = pk2(c.x, c.y); w.w = pk2(c.z, c.w);
        *(u32x4*)((isv ? CMV : CMK) + i8) = w;
    }
}

__device__ __forceinline__ void scan_seq(const Params& P, int sid, LAS unsigned char* lds, int tid) {
    asm volatile("" : "+v"(tid));
    const int lane = tid & 63, wave = tid >> 6;
    LAS float* wt = (LAS float*)lds;
    int L; float* dst; const float* src0; const float* src1; int split;
    if (sid < 32) { const int b = sid >> 3, h = sid & 7; L = SEQ; split = SEQ; src0 = P.out + O_LF_P + (size_t)b * SEQ * 8 + h; src1 = src0; dst = (float*)(P.ws + WS_BIASP) + (size_t)sid * SEQ; }
    else { const int s2 = sid - 32, b = s2 >> 3, h = s2 & 7; L = KTOT; split = PAST; src0 = P.cache_logf + (size_t)b * PAST * 8 + h;
           src1 = P.out + O_LF_S + (size_t)b * DSEQ * 8 + h - (size_t)PAST * 8; dst = (float*)(P.ws + WS_BIASS) + (size_t)s2 * KTOT; }
    float v[8]; float run = 0.f;
#pragma unroll
    for (int j = 0; j < 8; ++j) { const int pos = tid * 8 + j; float x = 0.f; if (pos < L) x = (pos < split) ? src0[(size_t)pos * 8] : src1[(size_t)pos * 8]; run += x; v[j] = run; }
    float inc = run;
#pragma unroll
    for (int o = 1; o < 64; o <<= 1) { const float t = __shfl_up(inc, o); if (lane >= o) inc += t; }
    if (lane == 63) wt[wave] = inc;
    __syncthreads();
    float base = inc - run;
    for (int w = 0; w < wave; ++w) base += wt[w];
#pragma unroll
    for (int j = 0; j < 8; ++j) { const int pos = tid * 8 + j; if (pos < L) dst[pos] = -(base + v[j]) * LOG2E; }
    __syncthreads();
}

struct AUnit { const bf16_t* Q; const bf16_t* K; const bf16_t* V; const float* bias; const bf16_t* G; bf16_t* O; int qp, kvp, gp, op, nq, ntiles, qpos0, causal; };

__device__ __forceinline__ s16x4 vtr(const LAS unsigned char* p) {
    typedef short v4i16_t __attribute__((ext_vector_type(4)));
    return __builtin_bit_cast(s16x4, __builtin_amdgcn_ds_read_tr16_b64_v4i16((LAS v4i16_t*)p));
}
__device__ __forceinline__ float swapmax(float m) { auto rr = __builtin_amdgcn_permlane32_swap(__float_as_uint(m), __float_as_uint(m), false, false); return fmaxf(__uint_as_float(rr[0]), __uint_as_float(rr[1])); }
__device__ __forceinline__ float swapsum(float m) { auto rr = __builtin_amdgcn_permlane32_swap(__float_as_uint(m), __float_as_uint(m), false, false); return __uint_as_float(rr[0]) + __uint_as_float(rr[1]); }

__device__ __forceinline__ float max3_asm(float a, float b, float c) { float r; asm("v_max3_f32 %0, %1, %2, %3" : "=v"(r) : "v"(a), "v"(b), "v"(c)); return r; }
__device__ __forceinline__ void attn_unit(const AUnit& U, LAS unsigned char* lds, int tid) {
    asm volatile("" : "+v"(tid));
    constexpr int KROW = 144, TILEB = 64 * KROW;
    const int lane = tid & 63, w = __builtin_amdgcn_readfirstlane(tid >> 6), r = lane & 31, h = lane >> 5;
    LAS unsigned char* Kb = lds; LAS unsigned char* Vb = lds + 2 * TILEB; LAS float* Bb = (LAS float*)(lds + 4 * TILEB);
    const bool active = (32 * w < U.nq);
    const int skey = tid >> 3, sch = tid & 7;
    const bf16_t* kg = U.K + (size_t)skey * U.kvp + sch * 8;
    const bf16_t* vg = U.V + (size_t)skey * U.kvp + sch * 8;
    const unsigned soff = skey * KROW + sch * 16;
    const size_t tstride = (size_t)64 * U.kvp;
    bf16x8 qf[4];
#pragma unroll
    for (int d0 = 0; d0 < 4; ++d0) qf[d0] = (bf16x8){0, 0, 0, 0, 0, 0, 0, 0};
    if (active) { const bf16_t* qrow = U.Q + (size_t)(32 * w + r) * U.qp + 8 * h;
#pragma unroll
        for (int d0 = 0; d0 < 4; ++d0) qf[d0] = *(const bf16x8*)(qrow + 16 * d0); }
    float m = -1e30f, l = 0.f; f32x16 o0, o1;
#pragma unroll
    for (int i = 0; i < 16; ++i) { o0[i] = 0.f; o1[i] = 0.f; }
    const int qpos = U.qpos0 + 32 * w + r;
    const int tlast = U.causal ? ((U.qpos0 + 32 * w + 31) >> 6) : (U.ntiles - 1);
    const bool hasb = (U.bias != nullptr) && (tid < 64);
    u32x4 kA = *(const u32x4*)kg, vA = *(const u32x4*)vg; float bA = hasb ? U.bias[tid] : 0.f;
    u32x4 kB = kA, vB = vA; float bB = 0.f;
    *(LAS u32x4*)(Kb + soff) = kA; *(LAS u32x4*)(Vb + soff) = vA; if (tid < 64) Bb[tid] = bA;
    if (U.ntiles > 1) { kA = *(const u32x4*)(kg + tstride); vA = *(const u32x4*)(vg + tstride); if (hasb) bA = U.bias[64 + tid]; }
    __syncthreads();
    const int q4 = (lane & 15) >> 2, p4 = lane & 3, blk = (lane >> 4) & 1;
    const unsigned voff = (4 * h + q4) * KROW + 32 * blk + 8 * p4;
    const unsigned koff = r * KROW + 16 * h;
#define ATT_STEP(t, WK, WV, WB, LK, LV, LB) do { \
        const int cur = (t) & 1; const bool more = ((t) + 1 < U.ntiles); \
        if ((t) + 2 < U.ntiles) { LK = *(const u32x4*)(kg + (size_t)((t) + 2) * tstride); LV = *(const u32x4*)(vg + (size_t)((t) + 2) * tstride); if (hasb) LB = U.bias[((t) + 2) * 64 + tid]; } \
        if (active && (t) <= tlast) { \
            const LAS unsigned char* Kt = Kb + cur * TILEB + koff; const LAS unsigned char* Vt = Vb + cur * TILEB + voff; const LAS float* Bt = Bb + cur * 64; \
            f32x16 sa, sb; \
            _Pragma("unroll") for (int g = 0; g < 4; ++g) { const f32x4 b0 = *(const LAS f32x4*)(Bt + 8 * g + 4 * h), b1 = *(const LAS f32x4*)(Bt + 32 + 8 * g + 4 * h); \
                _Pragma("unroll") for (int j = 0; j < 4; ++j) { sa[4 * g + j] = b0[j]; sb[4 * g + j] = b1[j]; } } \
            _Pragma("unroll") for (int d0 = 0; d0 < 4; ++d0) { const bf16x8 ka = *(const LAS bf16x8*)(Kt + 32 * d0), kb = *(const LAS bf16x8*)(Kt + 32 * KROW + 32 * d0); \
                sa = MFMA32(ka, qf[d0], sa); sb = MFMA32(kb, qf[d0], sb); } \
            if (U.causal && 64 * (t) + 63 > U.qpos0 + 32 * w) { \
                _Pragma("unroll") for (int i = 0; i < 16; ++i) { const int key = 64 * (t) + crow(i, h); if (key > qpos) sa[i] = -1e30f; if (key + 32 > qpos) sb[i] = -1e30f; } \
            } \
            asm volatile("s_nop 15\n\ts_nop 3" : "+v"(sa), "+v"(sb));     \
            float mx = max3_asm(sa[0], sb[0], sa[1]); mx = max3_asm(mx, sb[1], sa[2]); mx = max3_asm(mx, sb[2], sa[3]); mx = max3_asm(mx, sb[3], sa[4]); \
            float my = max3_asm(sb[4], sa[5], sb[5]); my = max3_asm(my, sa[6], sb[6]); my = max3_asm(my, sa[7], sb[7]); my = max3_asm(my, sa[8], sb[8]); \
            mx = max3_asm(mx, sa[9], sb[9]); mx = max3_asm(mx, sa[10], sb[10]); mx = max3_asm(mx, sa[11], sb[11]); mx = max3_asm(mx, sa[12], sb[12]); \
            my = max3_asm(my, sa[13], sb[13]); my = max3_asm(my, sa[14], sb[14]); my = max3_asm(my, sa[15], sb[15]); \
            mx = max3_asm(mx, my, m); \
            const float mnew = swapmax(mx), alpha = __builtin_amdgcn_exp2f(m - mnew); m = mnew; \
            float ls = 0.f; \
            _Pragma("unroll") for (int i = 0; i < 16; ++i) { sa[i] = __builtin_amdgcn_exp2f(sa[i] - mnew); sb[i] = __builtin_amdgcn_exp2f(sb[i] - mnew); ls += sa[i] + sb[i]; } \
            l = l * alpha + ls; \
            if (__builtin_amdgcn_ballot_w64(alpha < 1.f) != 0ull) { \
                _Pragma("unroll") for (int i = 0; i < 16; ++i) { o0[i] *= alpha; o1[i] *= alpha; } \
            } \
            bf16x8 pf[4]; \
            _Pragma("unroll") for (int s = 0; s < 2; ++s) { \
                u32x4 pa, pb; \
                pa.x = pk2(sa[8 * s], sa[8 * s + 1]); pa.y = pk2(sa[8 * s + 2], sa[8 * s + 3]); pa.z = pk2(sa[8 * s + 4], sa[8 * s + 5]); pa.w = pk2(sa[8 * s + 6], sa[8 * s + 7]); \
                pb.x = pk2(sb[8 * s], sb[8 * s + 1]); pb.y = pk2(sb[8 * s + 2], sb[8 * s + 3]); pb.z = pk2(sb[8 * s + 4], sb[8 * s + 5]); pb.w = pk2(sb[8 * s + 6], sb[8 * s + 7]); \
                pf[s] = __builtin_bit_cast(bf16x8, pa); pf[2 + s] = __builtin_bit_cast(bf16x8, pb); \
            } \
            _Pragma("unroll") for (int ks = 0; ks < 4; ++ks) { \
                _Pragma("unroll") for (int db = 0; db < 2; ++db) { \
                    const s16x4 lo = vtr(Vt + (16 * ks) * KROW + 64 * db), hi = vtr(Vt + (16 * ks + 8) * KROW + 64 * db); \
                    const bf16x8 vf = __builtin_shufflevector(lo, hi, 0, 1, 2, 3, 4, 5, 6, 7); \
                    if (db == 0) o0 = MFMA32(vf, pf[ks], o0); else o1 = MFMA32(vf, pf[ks], o1); \
                } \
            } \
        } \
        if (more) { const int nb = cur ^ 1; *(LAS u32x4*)(Kb + nb * TILEB + soff) = WK; *(LAS u32x4*)(Vb + nb * TILEB + soff) = WV; if (tid < 64) Bb[nb * 64 + tid] = WB; } \
        __syncthreads(); \
    } while (0)
    for (int t = 0; t < U.ntiles; t += 2) {
        ATT_STEP(t, kA, vA, bA, kB, vB, bB);
        if (t + 1 < U.ntiles) ATT_STEP(t + 1, kB, vB, bB, kA, vA, bA);
    }
#undef ATT_STEP
    if (active) {
        l = swapsum(l);
        const float inv = 1.0f / l;
        const size_t row = (size_t)(32 * w + r);
        const bf16_t* grow = U.G + row * U.gp; bf16_t* orow = U.O + row * U.op;
#pragma unroll
        for (int db = 0; db < 2; ++db)
#pragma unroll
            for (int g = 0; g < 4; ++g) {
                const int d = 32 * db + 8 * g + 4 * h;
                const u32x2 gv = *(const u32x2*)(grow + d);
                float a0, a1, a2, a3;
                if (db == 0) { a0 = o0[4 * g]; a1 = o0[4 * g + 1]; a2 = o0[4 * g + 2]; a3 = o0[4 * g + 3]; } else { a0 = o1[4 * g]; a1 = o1[4 * g + 1]; a2 = o1[4 * g + 2]; a3 = o1[4 * g + 3]; }
                u32x2 ov; ov.x = pk2(silu_f(bf_lo(gv.x)) * a0 * inv, silu_f(bf_hi(gv.x)) * a1 * inv); ov.y = pk2(silu_f(bf_lo(gv.y)) * a2 * inv, silu_f(bf_hi(gv.y)) * a3 * inv);
                *(u32x2*)(orow + d) = ov;
            }
    }
}

__device__ __forceinline__ void pool_unit(const Params& P, int tt, LAS unsigned char* lds, int tid) {
    asm volatile("" : "+v"(tid));
    const bf16_t* H = (const bf16_t*)(P.ws + WS_H); bf16_t* CAT = (bf16_t*)(P.ws + WS_XN);
    const int R0 = 64 * tt; const bool prompt = R0 < MP; const int s0 = prompt ? (R0 & (SEQ - 1)) : 0;
    LAS float* Ut = (LAS float*)lds;
    u32x4 wfr[4][2];
    {
        const int lane = tid & 63, wv = tid >> 6, r = lane & 31, h = lane >> 5, g = wv >> 1;
#pragma unroll
        for (int s = 0; s < 4; ++s) {
            const float* wp = P.w_pool + ((size_t)(g * 64) + 16 * s + 8 * h) * 64 + r;
            float t0[8], t1[8];
#pragma unroll
            for (int j = 0; j < 8; ++j) { t0[j] = wp[j * 64]; t1[j] = wp[j * 64 + 32]; }
            wfr[s][0].x = pk2(t0[0], t0[1]); wfr[s][0].y = pk2(t0[2], t0[3]); wfr[s][0].z = pk2(t0[4], t0[5]); wfr[s][0].w = pk2(t0[6], t0[7]);
            wfr[s][1].x = pk2(t1[0], t1[1]); wfr[s][1].y = pk2(t1[2], t1[3]); wfr[s][1].z = pk2(t1[4], t1[5]); wfr[s][1].w = pk2(t1[6], t1[7]);
        }
    }
    LAS bf16_t* Pt = (LAS bf16_t*)(lds + 81920);
    for (int e = tid; e < 79 * 32; e += 512) {
        const int rr = e >> 5, c8 = (e & 31) * 8, sl = rr - 15;
        f32x4 a = {0.f, 0.f, 0.f, 0.f}, c = {0.f, 0.f, 0.f, 0.f};
        if (sl >= 0 || (prompt && s0 + sl >= 0)) {
            const u32x4 hv = *(const u32x4*)(H + (size_t)(R0 + sl) * NH + C_U + c8);
            a = (f32x4){bf_lo(hv.x), bf_hi(hv.x), bf_lo(hv.y), bf_hi(hv.y)}; c = (f32x4){bf_lo(hv.z), bf_hi(hv.z), bf_lo(hv.w), bf_hi(hv.w)};
        } else if (!prompt) {
            const float* sp = P.state_pool + ((size_t)((R0 - MP) >> 6) * 15 + rr) * 256 + c8; a = *(const f32x4*)sp; c = *(const f32x4*)(sp + 4);
        }
        *(LAS f32x4*)(Ut + rr * 256 + c8) = a; *(LAS f32x4*)(Ut + rr * 256 + c8 + 4) = c;
    }
    __syncthreads();
    {
        const int c = tid & 255, half = tid >> 8, g = c >> 6, wn = 2 << g;
        const LAS float* uc = Ut + c;
        float sum = 0.f;
        for (int j = 1; j < wn; ++j) sum += uc[(15 + half * 32 - j) * 256];
        const float invw = 1.0f / (float)wn;
#pragma unroll 8
        for (int s = half * 32; s < half * 32 + 32; ++s) {
            const float us = uc[(15 + s) * 256];
            sum += us;
            float inv = invw;
            if (prompt && s0 + s + 1 < wn) inv = 1.0f / (float)(s0 + s + 1);
            const float pooled = sum * inv - us;
            Pt[s * 264 + c] = (bf16_t)(pk2(pooled, 0.f) & 0xffffu);
            sum -= uc[(15 + s - (wn - 1)) * 256];
        }
    }
    __syncthreads();
    {
        const int lane = tid & 63, wv = tid >> 6, r = lane & 31, h = lane >> 5, g = wv >> 1, th = wv & 1;
        f32x16 a0, a1;
#pragma unroll
        for (int i = 0; i < 16; ++i) { a0[i] = 0.f; a1[i] = 0.f; }
#pragma unroll
        for (int s = 0; s < 4; ++s) {
            const bf16x8 b = *(const LAS bf16x8*)(Pt + (32 * th + r) * 264 + g * 64 + 16 * s + 8 * h);
            a0 = MFMA32(__builtin_bit_cast(bf16x8, wfr[s][0]), b, a0); a1 = MFMA32(__builtin_bit_cast(bf16x8, wfr[s][1]), b, a1);
        }
        const size_t row = (size_t)(R0 + 32 * th + r);
#pragma unroll
        for (int db = 0; db < 2; ++db)
#pragma unroll
            for (int g4 = 0; g4 < 4; ++g4) {
                const int col = g * 64 + 32 * db + 8 * g4 + 4 * h;
                const f32x4 ps = *(const f32x4*)(P.pool_scale + col);
                const u32x2 gv = *(const u32x2*)(H + row * NH + C_GP + col);
                float v0, v1, v2, v3;
                if (db == 0) { v0 = a0[4 * g4]; v1 = a0[4 * g4 + 1]; v2 = a0[4 * g4 + 2]; v3 = a0[4 * g4 + 3]; } else { v0 = a1[4 * g4]; v1 = a1[4 * g4 + 1]; v2 = a1[4 * g4 + 2]; v3 = a1[4 * g4 + 3]; }
                u32x2 ov; ov.x = pk2(silu_f(bf_lo(gv.x)) * v0 * ps.x, silu_f(bf_hi(gv.x)) * v1 * ps.y); ov.y = pk2(silu_f(bf_lo(gv.y)) * v2 * ps.z, silu_f(bf_hi(gv.y)) * v3 * ps.w);
                *(u32x2*)(CAT + row * DM + 512 + col) = ov;
            }
    }
    __syncthreads();
}

constexpr int NU_FOXP = 512, NU_FOXS = 64, NU_MEMP = 256, NU_MEMS = 32, NU_POOL = MTOT / 64;
constexpr int NU_TOTAL = NU_FOXP + NU_FOXS + NU_MEMP + NU_MEMS + NU_POOL;

__device__ __forceinline__ void p2_unit(const Params& P, int idx, LAS unsigned char* lds, int tid) {
    const bf16_t* H = (const bf16_t*)(P.ws + WS_H); bf16_t* CAT = (bf16_t*)(P.ws + WS_XN);
    AUnit U;
    if (idx >= NU_FOXP + NU_FOXS && idx < NU_FOXP + NU_FOXS + NU_POOL) { pool_unit(P, idx - (NU_FOXP + NU_FOXS), lds, tid); return; }
    if (idx >= NU_FOXP + NU_FOXS) idx -= NU_POOL;
    if (idx < NU_FOXP) {
        const int qb = 15 - (idx >> 5), bh = idx & 31, b = bh >> 3, h = bh & 7; const size_t row0 = (size_t)b * SEQ + 256 * qb;
        U.Q = H + row0 * NH + C_Q + h * 64; U.K = H + (size_t)b * SEQ * NH + C_K + h * 64; U.V = H + (size_t)b * SEQ * NH + C_V + h * 64;
        U.bias = (const float*)(P.ws + WS_BIASP) + (size_t)bh * SEQ; U.G = H + row0 * NH + C_GF + h * 64; U.O = CAT + row0 * DM + h * 64;
        U.qp = NH; U.kvp = NH; U.gp = NH; U.op = DM; U.nq = 256; U.ntiles = 4 * qb + 4; U.qpos0 = 256 * qb; U.causal = 1;
    } else if (idx < NU_FOXP + NU_FOXS) {
        const int bh = idx - NU_FOXP, b = bh >> 3, h = bh & 7; const size_t row0 = (size_t)MP + b * DSEQ;
        U.Q = H + row0 * NH + C_Q + h * 64; U.K = (const bf16_t*)(P.ws + WS_KC) + (size_t)b * KTOT * 512 + h * 64; U.V = (const bf16_t*)(P.ws + WS_VC) + (size_t)b * KTOT * 512 + h * 64;
        U.bias = (const float*)(P.ws + WS_BIASS) + (size_t)bh * KTOT; U.G = H + row0 * NH + C_GF + h * 64; U.O = CAT + row0 * DM + h * 64;
        U.qp = NH; U.kvp = 512; U.gp = NH; U.op = DM; U.nq = 64; U.ntiles = KTOT / 64; U.qpos0 = PAST; U.causal = 1;
    } else if (idx < NU_FOXP + NU_FOXS + NU_MEMP) {
        const int i = idx - NU_FOXP - NU_FOXS, qb = i >> 4, b = (i >> 2) & 3, mh = i & 3; const size_t row0 = (size_t)b * SEQ + 256 * qb;
        const bf16_t* MKV = (const bf16_t*)(P.ws + WS_MKV);
        U.Q = H + row0 * NH + C_QM + mh * 64; U.K = MKV + (size_t)b * MEMT * 512 + mh * 64; U.V = U.K + 256;
        U.bias = nullptr; U.G = H + row0 * NH + C_GM + mh * 64; U.O = CAT + row0 * DM + 768 + mh * 64;
        U.qp = NH; U.kvp = 512; U.gp = NH; U.op = DM; U.nq = 256; U.ntiles = 4; U.qpos0 = 0; U.causal = 0;
    } else if (idx < NU_FOXP + NU_FOXS + NU_MEMP + NU_MEMS) {
        const int i = idx - NU_FOXP - NU_FOXS - NU_MEMP, b = i >> 2, mh = i & 3; const size_t row0 = (size_t)MP + b * DSEQ;
        U.Q = H + row0 * NH + C_QM + mh * 64; U.K = (const bf16_t*)(P.ws + WS_CMK) + (size_t)b * MEMT * 256 + mh * 64; U.V = (const bf16_t*)(P.ws + WS_CMV) + (size_t)b * MEMT * 256 + mh * 64;
        U.bias = nullptr; U.G = H + row0 * NH + C_GM + mh * 64; U.O = CAT + row0 * DM + 768 + mh * 64;
        U.qp = NH; U.kvp = 256; U.gp = NH; U.op = DM; U.nq = 64; U.ntiles = 4; U.qpos0 = 0; U.causal = 0;
    } else return;
    attn_unit(U, lds, tid);
}

__global__ void __launch_bounds__(512, 2) hymba_fwd(Params P) {
    extern __shared__ __attribute__((aligned(16))) unsigned char lds_raw[];
    LAS unsigned char* lds = (LAS unsigned char*)lds_raw;
    cg::grid_group grid = cg::this_grid();
    const int tid = threadIdx.x, G = gridDim.x;
    unsigned char* ws = P.ws;
    if (P.out == nullptr) grid.sync();
    volatile LAS unsigned* MISC = (volatile LAS unsigned*)(lds + LDS_MISC);
    if (tid < 2) MISC[tid] = 0u;
    __syncthreads();
    XcdBarrier bar = xcd_barrier_post((unsigned*)(ws + WS_CTL) + CW_BAR, MISC);
#define GRID_SYNC() xcd_barrier(bar)

    p0_prologue(P, lds, tid, G);
    GRID_SYNC();

    for (int sid = G - 1 - (int)blockIdx.x; sid < 96; sid += G) scan_seq(P, sid, lds, tid);
    {
        pg8::Gemm g{(const bf16_t*)(ws + WS_XN), (const bf16_t*)(ws + WS_WIN), MTOT, NH, DM}; pg8::StaticOrder S; S.init(MTOT, NH, G, (int)blockIdx.x);
        pg8::EpiIn E{(bf16_t*)(ws + WS_H), P.out, (bf16_t*)(ws + WS_KC), (bf16_t*)(ws + WS_VC)};
        pg8::gemm_phase<pg8::EpiIn, pg8::StaticOrder, true, true>(lds, g, S, E);
    }
    {
        pg8::Gemm g{(const bf16_t*)(ws + WS_MEMN), (const bf16_t*)(ws + WS_WMEM), MMEM, 512, DM}; pg8::StaticOrder S; S.init(MMEM, 512, G, (int)((blockIdx.x + G - (24 % G)) % G));
        pg8::EpiMem E{(bf16_t*)(ws + WS_MKV), P.out};
        pg8::gemm_phase<pg8::EpiMem, pg8::StaticOrder, true, true>(lds, g, S, E);
    }
    GRID_SYNC();

    {
        unsigned* qhead = (unsigned*)(ws + WS_CTL);
        volatile LAS int* slot = (volatile LAS int*)(lds + LDS_Q);
        for (;;) {
            if (tid == 0) *slot = (int)atomicAdd(qhead, 1u);
            __syncthreads();
            const int idx = *slot;
            __syncthreads();
            if (idx >= NU_TOTAL) break;
            p2_unit(P, idx, lds, tid);
        }
    }
    GRID_SYNC();

    {
        pg8::Gemm g{(const bf16_t*)(ws + WS_XN), (const bf16_t*)(ws + WS_WOUT), MTOT, DM, DM}; pg8::StaticOrder S; S.init(MTOT, DM, G, (int)blockIdx.x);
        pg8::EpiOut E{P.x_prompt, P.x_sample, P.out + O_Y};
        pg8::gemm_phase<pg8::EpiOut, pg8::StaticOrder, true, true>(lds, g, S, E);
    }
    GRID_SYNC();

    {
        int tid4 = tid; asm volatile("" : "+v"(tid4));
        const int lane = tid4 & 63, gw = blockIdx.x * 8 + (tid4 >> 6), NGW = G * 8;
        const f32x4* gr = (const f32x4*)P.g_final + lane;
        for (int m = gw; m < MTOT; m += NGW) {
            f32x4* yr = (f32x4*)(P.out + O_Y + (size_t)m * DM) + lane;
            f32x4 v[4]; float s = 0.f;
#pragma unroll
            for (int j = 0; j < 4; ++j) { v[j] = yr[64 * j]; s += (v[j].x * v[j].x + v[j].y * v[j].y) + (v[j].z * v[j].z + v[j].w * v[j].w); }
            const float rs = 1.0f / sqrtf(wave_sum(s) * (1.f / DM) + EPS);
#pragma unroll
            for (int j = 0; j < 4; ++j) yr[64 * j] = v[j] * rs * gr[64 * j];
        }
    }
}

extern "C" void kernel_launch(void* const* d_in, const int* in_sizes, int n_in, void* d_out, int out_size, void* d_ws, size_t ws_size, hipStream_t stream) {
    static int grid = 0;
    if (grid == 0) {
        int dev = 0, cus = 0, per_cu = 0;
        hipGetDevice(&dev);
        hipDeviceGetAttribute(&cus, hipDeviceAttributeMultiprocessorCount, dev);
        hipFuncSetAttribute((const void*)hymba_fwd, hipFuncAttributeMaxDynamicSharedMemorySize, LDS_BYTES);
        hipOccupancyMaxActiveBlocksPerMultiprocessor(&per_cu, (const void*)hymba_fwd, 512, LDS_BYTES);
        if (per_cu < 1) { fprintf(stderr, "kernel_launch: occupancy query says %d blocks/CU\n", per_cu); per_cu = 1; }
        (void)hipGetLastError();
        grid = cus;
        if (ws_size < WS_END) { fprintf(stderr, "kernel_launch: workspace too small\n"); grid = -1; }
    }
    if (grid < 0) return;
    if (hipMemsetAsync((char*)d_ws + WS_CTL, 0, CTL_ZERO_BYTES, stream) != hipSuccess) { fprintf(stderr, "kernel_launch: memset failed\n"); return; }
    Params p{};
    p.x_prompt = (const float*)d_in[0]; p.x_sample = (const float*)d_in[1]; p.mem_prompt = (const float*)d_in[2]; p.cache_k = (const float*)d_in[3];
    p.cache_v = (const float*)d_in[4]; p.cache_logf = (const float*)d_in[5]; p.cache_mk = (const float*)d_in[6]; p.cache_mv = (const float*)d_in[7];
    p.state_pool = (const float*)d_in[8]; p.g_norm = (const float*)d_in[9]; p.w_in = (const float*)d_in[10]; p.b_f = (const float*)d_in[11];
    p.w_pool = (const float*)d_in[12]; p.pool_scale = (const float*)d_in[13]; p.g_mem = (const float*)d_in[14]; p.w_mem_kv = (const float*)d_in[15];
    p.w_out = (const float*)d_in[16]; p.g_final = (const float*)d_in[17];
    p.out = (float*)d_out; p.ws = (unsigned char*)d_ws;
    void* args[] = {&p};
    hipError_t e = hipLaunchCooperativeKernel((const void*)hymba_fwd, dim3(grid), dim3(512), args, LDS_BYTES, stream);
    if (e != hipSuccess) fprintf(stderr, "cooperative launch failed: %s (grid %d)\n", hipGetErrorString(e), grid);
}
```
